# Optimizing an MI355X kernel written in HIP

```python
import math
import jax, jax.numpy as jnp
from jax import lax
import numpy as np

D_MODEL = 1024
BATCH = 4
SEQ = 8192
DEPTH = 2

GRID_W = 64
CTX_LEN = 256
N_EVEN = (DEPTH + 1) // 2
N_ODD = DEPTH // 2

ATTN_WIDTH = D_MODEL // 2
POOL_WIDTH = D_MODEL // 2
DIFF_HEADS = 4
DIFF_HEAD_DIM = ATTN_WIDTH // (2 * DIFF_HEADS)
VAL_HEAD_DIM = 2 * DIFF_HEAD_DIM
POOL_WINDOWS = (2, 4, 8, 16)
POOL_GROUP = POOL_WIDTH // len(POOL_WINDOWS)
Q_BLOCK = 128
ROPE_BASE = 10000.0

SSM_WIDTH = D_MODEL
SSM_GROUP = 16
SSM_GROUPS = SSM_WIDTH // SSM_GROUP
SSM_STATE = 64

N_EXPERTS = 16
EXPERT_HIDDEN = 2 * D_MODEL
CAPACITY_FACTOR = 2

EPS = 1e-6
F32 = jnp.float32

kernel_name = "hybrid_diffattn_pool_s5_ecmoe_prefix_ctx"


def rms_norm(x, g):
    xf = x.astype(F32)
    y = xf * lax.rsqrt(jnp.mean(xf * xf, axis=-1, keepdims=True) + EPS)
    return (y * g.astype(F32)).astype(x.dtype)


def modulate(h, shift, scale):
    return h * (1 + scale[:, None, :]) + shift[:, None, :]


def axial_rope_tables(n_tokens):
    rows = n_tokens // GRID_W
    row = jnp.repeat(jnp.arange(rows, dtype=F32), GRID_W)
    col = jnp.tile(jnp.arange(GRID_W, dtype=F32), rows)
    n_freq = DIFF_HEAD_DIM // 4
    inv_freq = ROPE_BASE ** (-jnp.arange(n_freq, dtype=F32) / n_freq)
    ang = jnp.stack([row, col], axis=-1)[:, :, None] * inv_freq
    return jnp.cos(ang), jnp.sin(ang)


def apply_axial_rope(x, cos, sin):
    B, S, H, M, dh = x.shape
    xf = x.astype(F32).reshape(B, S, H, M, 2, 2, dh // 4)
    x1, x2 = xf[..., 0, :], xf[..., 1, :]
    cb = cos[None, :, None, None]
    sb = sin[None, :, None, None]
    out = jnp.stack([x1 * cb - x2 * sb, x2 * cb + x1 * sb], axis=-2)
    return out.reshape(x.shape).astype(x.dtype)


def diff_attend(q, k, v, lam):
    s = jnp.einsum('bqhmd,bkhmd->bhmqk', q, k, preferred_element_type=F32)
    p = jax.nn.softmax(s, axis=-1)
    w = (p[:, :, 0] - lam * p[:, :, 1]).astype(v.dtype)
    return jnp.einsum('bhqk,bkhe->bqhe', w, v)


def multiscale_pool(u, pool_w, pool_scale):
    B, n, _ = u.shape
    uf = u.astype(F32)
    cs = jnp.concatenate([jnp.zeros((B, 1, POOL_WIDTH), F32), lax.cumsum(uf, axis=1)], axis=1)
    t = jnp.arange(n)
    groups = []
    for gi, w in enumerate(POOL_WINDOWS):
        lo = jnp.clip(t - w // 2, 0, n - 1)
        hi = jnp.clip(t + w // 2 - 1, 0, n - 1) + 1
        sl = slice(gi * POOL_GROUP, (gi + 1) * POOL_GROUP)
        csg = cs[:, :, sl]
        mean = (csg[:, hi] - csg[:, lo]) / (hi - lo).astype(F32)[None, :, None]
        groups.append(mean - uf[:, :, sl])
    d = jnp.stack(groups, axis=2).astype(u.dtype)
    y = jnp.einsum('bngc,gce->bnge', d, pool_w).reshape(B, n, POOL_WIDTH)
    return y * pool_scale


def _split_even_heads(z):
    B, n, _ = z.shape
    q, k, v, u = jnp.split(z, [ATTN_WIDTH, 2 * ATTN_WIDTH, 3 * ATTN_WIDTH], axis=-1)
    q = q.reshape(B, n, DIFF_HEADS, 2, DIFF_HEAD_DIM) * (DIFF_HEAD_DIM ** -0.5)
    k = k.reshape(B, n, DIFF_HEADS, 2, DIFF_HEAD_DIM)
    v = v.reshape(B, n, DIFF_HEADS, VAL_HEAD_DIM)
    return q, k, v, u


def even_mixer(h_lat, h_ctx, w_in, w_out, lq1, lk1, lq2, lk2, subln_g, pool_w, pool_scale,
               cos, sin, layer_idx, ctx_out):
    lam_init = 0.8 - 0.6 * math.exp(-0.3 * layer_idx)
    lam = (jnp.exp(jnp.sum(lq1.astype(F32) * lk1.astype(F32)))
           - jnp.exp(jnp.sum(lq2.astype(F32) * lk2.astype(F32))) + lam_init)
    B, S, _ = h_lat.shape
    q_l, k_l, v_l, u_l = _split_even_heads(h_lat @ w_in)
    q_c, k_c, v_c, u_c = _split_even_heads(h_ctx @ w_in)
    q_l = apply_axial_rope(q_l, cos, sin)
    k_l = apply_axial_rope(k_l, cos, sin)
    k_all = jnp.concatenate([k_c, k_l], axis=1)
    v_all = jnp.concatenate([v_c, v_l], axis=1)
    n_blk = S // Q_BLOCK
    qb = q_l.reshape(B, n_blk, Q_BLOCK, DIFF_HEADS, 2, DIFF_HEAD_DIM).transpose(1, 0, 2, 3, 4, 5)
    ob = lax.map(lambda qblk: diff_attend(qblk, k_all, v_all, lam), qb)
    o_l = ob.transpose(1, 0, 2, 3, 4).reshape(B, S, DIFF_HEADS, VAL_HEAD_DIM)

    def merge(o, u):
        b, n = o.shape[:2]
        o = rms_norm(o, subln_g) * (1 - lam_init)
        y = jnp.concatenate([o.reshape(b, n, ATTN_WIDTH),
                             multiscale_pool(u, pool_w, pool_scale).astype(o.dtype)], axis=-1)
        return y @ w_out

    y_lat = merge(o_l, u_l)
    y_ctx = merge(diff_attend(q_c, k_c, v_c, lam), u_c) if ctx_out else None
    return y_lat, y_ctx


def s5_discretize(lam_re, lam_im, log_dt, b_re, b_im):
    lam = lax.complex(lam_re.astype(F32), lam_im.astype(F32))
    dt = jnp.exp(log_dt.astype(F32))[:, None]
    a_bar = jnp.exp(lam * dt)
    b = lax.complex(b_re.astype(F32), b_im.astype(F32))
    b_bar = ((a_bar - 1) / lam)[..., None] * b
    return a_bar, b_bar


def _ssm_combine(left, right):
    a_l, b_l = left
    a_r, b_r = right
    return a_r * a_l, a_r * b_l + b_r


def _ssm_readout(c_mat, s):
    y = jnp.real(jnp.einsum('gcn,bsgn->bsgc', c_mat, s))
    return y.reshape(s.shape[0], s.shape[1], SSM_WIDTH)


def odd_mixer(h_lat, h_ctx, w_in, lam_re, lam_im, log_dt, b_re, b_im, c_re, c_im, d_skip,
              w_glu, w_out, ctx_out):
    B, S, _ = h_lat.shape
    n_ctx = h_ctx.shape[1]
    u_lat = (h_lat @ w_in).astype(F32)
    u_ctx = (h_ctx @ w_in).astype(F32)
    ug_lat = u_lat.reshape(B, S, SSM_GROUPS, SSM_GROUP).astype(jnp.complex64)
    ug_ctx = u_ctx.reshape(B, n_ctx, SSM_GROUPS, SSM_GROUP).astype(jnp.complex64)
    d = d_skip.astype(F32)
    y_lat = u_lat * d
    y_ctx = u_ctx * d
    for direction in range(2):
        a_bar, b_bar = s5_discretize(lam_re[direction], lam_im[direction], log_dt[direction],
                                     b_re[direction], b_im[direction])
        c_mat = lax.complex(c_re[direction].astype(F32), c_im[direction].astype(F32))
        bu_ctx = jnp.einsum('gnc,bsgc->bsgn', b_bar, ug_ctx)
        bu_lat = jnp.einsum('gnc,bsgc->bsgn', b_bar, ug_lat)
        if direction == 0:
            seq = jnp.concatenate([bu_ctx, bu_lat], axis=1)
            a = jnp.broadcast_to(a_bar, (1, seq.shape[1]) + a_bar.shape)
            _, states = lax.associative_scan(_ssm_combine, (a, seq), axis=1)
            s_ctx, s_lat = states[:, :n_ctx], states[:, n_ctx:]
        else:
            seq = jnp.concatenate([bu_lat, bu_ctx], axis=1)
            a = jnp.broadcast_to(a_bar, (1, seq.shape[1]) + a_bar.shape)
            _, states = lax.associative_scan(_ssm_combine, (a, seq), reverse=True, axis=1)
            s_lat, s_ctx = states[:, :S], states[:, S:]
        y_lat = y_lat + _ssm_readout(c_mat, s_lat)
        if ctx_out:
            y_ctx = y_ctx + _ssm_readout(c_mat, s_ctx)

    def glu_out(y, dtype):
        z = jax.nn.gelu(y.astype(dtype))
        return (z * jax.nn.sigmoid(z @ w_glu)) @ w_out

    out_lat = glu_out(y_lat, h_lat.dtype)
    out_ctx = glu_out(y_ctx, h_ctx.dtype) if ctx_out else None
    return out_lat, out_ctx


def expert_choice_ffn(h, router_w, w_gate, w_up, w_down):
    B, n, D = h.shape
    cap = CAPACITY_FACTOR * n // N_EXPERTS
    logits = jnp.einsum('bnd,de->ben', h, router_w, preferred_element_type=F32)
    affinity = jax.nn.softmax(logits, axis=1)
    g, idx = lax.top_k(affinity, cap)
    xs = jax.vmap(lambda hb, ib: hb[ib])(h, idx)
    a = jnp.einsum('becd,edf->becf', xs, w_gate)
    u = jnp.einsum('becd,edf->becf', xs, w_up)
    out = jnp.einsum('becf,efd->becd', jax.nn.silu(a) * u, w_down)
    out = out * g[..., None].astype(out.dtype)
    return jax.vmap(lambda ib, ob: jnp.zeros((n, D), ob.dtype).at[ib].add(ob))(
        idx.reshape(B, -1), out.reshape(B, -1, D))


def setup_inputs(seed: int = 0) -> dict:
    key = jax.random.key(seed)
    ks = jax.random.split(key, 40)
    D = D_MODEL

    def nrm(k, shape, scale):
        return jax.random.normal(k, shape, F32) * scale

    n_idx = jnp.arange(SSM_STATE, dtype=F32)
    ssm_shape = (N_ODD, 2, SSM_GROUPS, SSM_STATE)
    return {
        "x": nrm(ks[0], (BATCH, SEQ, D), 1.0),
        "c": nrm(ks[1], (BATCH, D), 1.0),
        "ctx": nrm(ks[2], (BATCH, CTX_LEN, D), 1.0),
        "c_ctx": nrm(ks[3], (D,), 1.0),
        "ada_w": nrm(ks[4], (DEPTH, D, 6 * D), 0.5 * D ** -0.5),
        "ada_b": nrm(ks[5], (DEPTH, 6 * D), 0.01),
        "norm_mix_g": 1.0 + nrm(ks[6], (DEPTH, D), 0.01),
        "norm_ffn_g": 1.0 + nrm(ks[7], (DEPTH, D), 0.01),
        "router_w": nrm(ks[8], (DEPTH, D, N_EXPERTS), D ** -0.5),
        "exp_w_gate": nrm(ks[9], (DEPTH, N_EXPERTS, D, EXPERT_HIDDEN), D ** -0.5),
        "exp_w_up": nrm(ks[10], (DEPTH, N_EXPERTS, D, EXPERT_HIDDEN), D ** -0.5),
        "exp_w_down": nrm(ks[11], (DEPTH, N_EXPERTS, EXPERT_HIDDEN, D), EXPERT_HIDDEN ** -0.5),
        "attn_w_in": nrm(ks[12], (N_EVEN, D, 3 * ATTN_WIDTH + POOL_WIDTH), D ** -0.5),
        "attn_w_out": nrm(ks[13], (N_EVEN, ATTN_WIDTH + POOL_WIDTH, D), (ATTN_WIDTH + POOL_WIDTH) ** -0.5),
        "lambda_q1": nrm(ks[14], (N_EVEN, DIFF_HEAD_DIM), 0.1),
        "lambda_k1": nrm(ks[15], (N_EVEN, DIFF_HEAD_DIM), 0.1),
        "lambda_q2": nrm(ks[16], (N_EVEN, DIFF_HEAD_DIM), 0.1),
        "lambda_k2": nrm(ks[17], (N_EVEN, DIFF_HEAD_DIM), 0.1),
        "subln_g": 1.0 + nrm(ks[18], (N_EVEN, VAL_HEAD_DIM), 0.01),
        "pool_w": nrm(ks[19], (N_EVEN, len(POOL_WINDOWS), POOL_GROUP, POOL_GROUP), POOL_GROUP ** -0.5),
        "pool_scale": 1.0 + nrm(ks[20], (N_EVEN, POOL_WIDTH), 0.1),
        "ssm_w_in": nrm(ks[21], (N_ODD, D, SSM_WIDTH), D ** -0.5),
        "ssm_lambda_re": -0.5 + nrm(ks[22], ssm_shape, 0.01),
        "ssm_lambda_im": math.pi * n_idx + nrm(ks[23], ssm_shape, 0.01),
        "ssm_log_dt": jax.random.uniform(ks[24], (N_ODD, 2, SSM_GROUPS), F32,
                                         math.log(1e-3), math.log(1e-1)),
        "ssm_b_re": nrm(ks[25], (N_ODD, 2, SSM_GROUPS, SSM_STATE, SSM_GROUP), (2 * SSM_GROUP) ** -0.5),
        "ssm_b_im": nrm(ks[26], (N_ODD, 2, SSM_GROUPS, SSM_STATE, SSM_GROUP), (2 * SSM_GROUP) ** -0.5),
        "ssm_c_re": nrm(ks[27], (N_ODD, 2, SSM_GROUPS, SSM_GROUP, SSM_STATE), 0.5),
        "ssm_c_im": nrm(ks[28], (N_ODD, 2, SSM_GROUPS, SSM_GROUP, SSM_STATE), 0.5),
        "ssm_d": nrm(ks[29], (N_ODD, SSM_WIDTH), 1.0),
        "ssm_w_glu": nrm(ks[30], (N_ODD, SSM_WIDTH, SSM_WIDTH), SSM_WIDTH ** -0.5),
        "ssm_w_out": nrm(ks[31], (N_ODD, SSM_WIDTH, D), SSM_WIDTH ** -0.5),
        "final_norm_g": 1.0 + nrm(ks[32], (D,), 0.01),
    }


def reference(x, c, ctx, c_ctx, ada_w, ada_b, norm_mix_g, norm_ffn_g, router_w, exp_w_gate, exp_w_up,
              exp_w_down, attn_w_in, attn_w_out, lambda_q1, lambda_k1, lambda_q2, lambda_k2, subln_g, pool_w,
              pool_scale, ssm_w_in, ssm_lambda_re, ssm_lambda_im, ssm_log_dt, ssm_b_re, ssm_b_im, ssm_c_re,
              ssm_c_im, ssm_d, ssm_w_glu, ssm_w_out, final_norm_g):
    S = x.shape[1]
    cos, sin = axial_rope_tables(S)
    h_lat, h_ctx = x, ctx
    cond_lat = jax.nn.silu(c)
    cond_ctx = jax.nn.silu(c_ctx)[None]
    for layer in range(DEPTH):
        ctx_out = layer < DEPTH - 1
        ml = jnp.split(cond_lat @ ada_w[layer] + ada_b[layer], 6, axis=-1)
        mc = jnp.split(cond_ctx @ ada_w[layer] + ada_b[layer], 6, axis=-1)
        a_lat = modulate(rms_norm(h_lat, norm_mix_g[layer]), ml[0], ml[1])
        a_ctx = modulate(rms_norm(h_ctx, norm_mix_g[layer]), mc[0], mc[1])
        i = layer // 2
        if layer % 2 == 0:
            m_lat, m_ctx = even_mixer(a_lat, a_ctx, attn_w_in[i], attn_w_out[i], lambda_q1[i], lambda_k1[i],
                                      lambda_q2[i], lambda_k2[i], subln_g[i], pool_w[i], pool_scale[i],
                                      cos, sin, layer, ctx_out)
        else:
            m_lat, m_ctx = odd_mixer(a_lat, a_ctx, ssm_w_in[i], ssm_lambda_re[i], ssm_lambda_im[i],
                                     ssm_log_dt[i], ssm_b_re[i], ssm_b_im[i], ssm_c_re[i], ssm_c_im[i],
                                     ssm_d[i], ssm_w_glu[i], ssm_w_out[i], ctx_out)
        h_lat = h_lat + ml[2][:, None, :] * m_lat
        f_lat = modulate(rms_norm(h_lat, norm_ffn_g[layer]), ml[3], ml[4])
        h_lat = h_lat + ml[5][:, None, :] * expert_choice_ffn(f_lat, router_w[layer], exp_w_gate[layer],
                                                              exp_w_up[layer], exp_w_down[layer])
        if ctx_out:
            h_ctx = h_ctx + mc[2][:, None, :] * m_ctx
            f_ctx = modulate(rms_norm(h_ctx, norm_ffn_g[layer]), mc[3], mc[4])
            h_ctx = h_ctx + mc[5][:, None, :] * expert_choice_ffn(f_ctx, router_w[layer], exp_w_gate[layer],
                                                                  exp_w_up[layer], exp_w_down[layer])
    return rms_norm(h_lat, final_norm_g)
```

```cpp
#include <hip/hip_runtime.h>
#include <cstdio>
#include <cstdint>

#define LAS __attribute__((address_space(3)))
#define GAS __attribute__((address_space(1)))
typedef unsigned short bf16_t;
typedef short bf16x8 __attribute__((ext_vector_type(8)));
typedef short s16x4 __attribute__((ext_vector_type(4)));
typedef float f32x2 __attribute__((ext_vector_type(2)));
typedef float f32x4 __attribute__((ext_vector_type(4)));
typedef float f32x16 __attribute__((ext_vector_type(16)));
typedef unsigned u32x2 __attribute__((ext_vector_type(2)));
typedef unsigned u32x4 __attribute__((ext_vector_type(4)));

constexpr int NB = 4, SEQ = 8192, DM = 1024, CTXL = 256;
constexpr int SP = SEQ + CTXL;
constexpr int NTOK = NB * SP;
constexpr int NLAT = NB * SEQ;
constexpr int NEXP = 16, EHID = 2048, CAPL = 1024, CAPC = 32;
constexpr int XROWS = 4352;
constexpr int SG = 64, SN = 64, SC = 16, SL = 32;
constexpr int NCHL = SEQ / SL, NCHC = CTXL / SL;
constexpr int UROWS = 1280, UK = 768;
constexpr float EPSN = 1e-6f;

constexpr size_t MiB = 1u << 20;
constexpr size_t WS_CTL = 0, CTL_ZERO_BYTES = 1 * MiB;
constexpr size_t WS_MOD = 1 * MiB;
constexpr size_t WS_ROPE = 1 * MiB + 256 * 1024;
constexpr size_t WS_LAM = 1 * MiB + 320 * 1024;
constexpr size_t WS_APOW = 2 * MiB;
constexpr size_t WS_BBAR = 5 * MiB;
constexpr size_t WS_KTAB = 6 * MiB;
constexpr size_t WS_AFF = 10 * MiB;
constexpr size_t WS_AFFC = 12 * MiB;
constexpr size_t WS_SLOT = 13 * MiB;
constexpr size_t WS_SLOTC = 15 * MiB;
constexpr size_t WS_TOK = 15 * MiB + 512 * 1024;
constexpr size_t WS_HC = 16 * MiB;
constexpr size_t WS_HB = 954 * MiB;
constexpr size_t WS_WIN = 20 * MiB;
constexpr size_t WS_WOUT = 24 * MiB;
constexpr size_t WS_SWIN = 26 * MiB, WS_SWGLU = 28 * MiB, WS_SWOUT = 30 * MiB;
constexpr size_t WS_TQ = 32 * MiB;
constexpr size_t WS_POP = 80 * MiB;
constexpr size_t WS_GU = 96 * MiB;
constexpr size_t WS_DN = 352 * MiB;
constexpr size_t WS_A1 = 480 * MiB;
constexpr size_t WS_Z = 546 * MiB;
constexpr size_t WS_Y1 = 678 * MiB;
constexpr size_t WS_XS = 546 * MiB;
constexpr size_t WS_HID = 682 * MiB;
constexpr size_t WS_U = 546 * MiB;
constexpr size_t WS_SLOC = 666 * MiB;
constexpr size_t WS_ZG = 746 * MiB;
constexpr size_t WS_ZZ = 810 * MiB;
constexpr size_t WS_END = 1020 * MiB;
static_assert(WS_A1 + (size_t)NTOK * DM * 2 <= WS_Z && WS_Z + (size_t)NTOK * 2048 * 2 <= WS_Y1 && WS_XS + (size_t)16 * XROWS * 1024 * 2 <= WS_HID &&
              WS_HID + (size_t)16 * XROWS * 2048 * 2 <= WS_END && WS_U + (size_t)64 * UROWS * UK * 2 <= WS_SLOC && WS_SLOC + (size_t)64 * UROWS * 256 * 4 <= WS_ZG &&
              WS_ZG + (size_t)NLAT * DM * 2 <= WS_ZZ && WS_ZZ + (size_t)NLAT * DM * 2 <= WS_END && WS_Y1 + (size_t)NTOK * DM * 2 <= WS_END, "ws map");
static_assert(WS_GU + (size_t)2 * 16 * 4096 * 1024 * 2 <= WS_DN && WS_DN + (size_t)2 * 16 * 1024 * 2048 * 2 <= WS_A1 && WS_TQ + (size_t)64 * 512 * 768 * 2 <= WS_POP && WS_POP + (size_t)64 * 256 * 512 * 2 <= WS_GU, "ws map 2");
static_assert(WS_APOW + (size_t)2 * 64 * 64 * 33 * 8 <= WS_BBAR && WS_BBAR + (size_t)2 * 64 * 64 * 16 * 8 <= WS_KTAB && WS_KTAB + (size_t)2 * 64 * 32 * 256 * 4 <= WS_AFF, "ws map 3");
constexpr int CW_BAR = 4096;

constexpr int RING_BYTES = 131072;
constexpr int MISC_OFF = 147456 - 256;
constexpr int LDS_BYTES = 147456;
constexpr int NWAVES = 8, NTHR = 512;

typedef __bf16 bf16x2_t __attribute__((ext_vector_type(2)));
__device__ __forceinline__ unsigned cvt_pk_bf16(float lo, float hi) { const bf16x2_t r = __builtin_convertvector((f32x2){lo, hi}, bf16x2_t); return __builtin_bit_cast(unsigned, r); }
__device__ __forceinline__ float bf2f(unsigned short b) { return __uint_as_float(((unsigned)b) << 16); }
__device__ __forceinline__ float bflo(unsigned w) { return __uint_as_float(w << 16); }
__device__ __forceinline__ float bfhi(unsigned w) { return __uint_as_float(w & 0xffff0000u); }
#define DPP_I(x, ctrl) __builtin_amdgcn_update_dpp(0, (x), (ctrl), 0xF, 0xF, true)
__device__ __forceinline__ float dpp_f(float v, const int ctrl_unused) { (void)ctrl_unused; return v; }
__device__ __forceinline__ float row16_sum(float v) {
    v += __builtin_bit_cast(float, DPP_I(__builtin_bit_cast(int, v), 0xB1));
    v += __builtin_bit_cast(float, DPP_I(__builtin_bit_cast(int, v), 0x4E));
    v += __builtin_bit_cast(float, DPP_I(__builtin_bit_cast(int, v), 0x141));
    v += __builtin_bit_cast(float, DPP_I(__builtin_bit_cast(int, v), 0x140));
    return v;
}
__device__ __forceinline__ float half32_sum(float v) {
    v = row16_sum(v);
    const auto r = __builtin_amdgcn_permlane16_swap(__float_as_uint(v), __float_as_uint(v), false, false);
    return __uint_as_float(r[0]) + __uint_as_float(r[1]);
}
__device__ __forceinline__ float wave_sum(float v) {
    v = half32_sum(v);
    const auto r = __builtin_amdgcn_permlane32_swap(__float_as_uint(v), __float_as_uint(v), false, false);
    return __uint_as_float(r[0]) + __uint_as_float(r[1]);
}
__device__ __forceinline__ int wave_sum_i(int v) {
    v += DPP_I(v, 0xB1); v += DPP_I(v, 0x4E); v += DPP_I(v, 0x141); v += DPP_I(v, 0x140);
    { const auto r = __builtin_amdgcn_permlane16_swap((unsigned)v, (unsigned)v, false, false); v = (int)(r[0] + r[1]); }
    { const auto r = __builtin_amdgcn_permlane32_swap((unsigned)v, (unsigned)v, false, false); v = (int)(r[0] + r[1]); }
    return v;
}
__device__ __forceinline__ float wave_max(float v) {
    v = fmaxf(v, __builtin_bit_cast(float, DPP_I(__builtin_bit_cast(int, v), 0xB1))); v = fmaxf(v, __builtin_bit_cast(float, DPP_I(__builtin_bit_cast(int, v), 0x4E)));
    v = fmaxf(v, __builtin_bit_cast(float, DPP_I(__builtin_bit_cast(int, v), 0x141))); v = fmaxf(v, __builtin_bit_cast(float, DPP_I(__builtin_bit_cast(int, v), 0x140)));
    { const auto r = __builtin_amdgcn_permlane16_swap(__float_as_uint(v), __float_as_uint(v), false, false); v = fmaxf(__uint_as_float(r[0]), __uint_as_float(r[1])); }
    { const auto r = __builtin_amdgcn_permlane32_swap(__float_as_uint(v), __float_as_uint(v), false, false); v = fmaxf(__uint_as_float(r[0]), __uint_as_float(r[1])); }
    return v;
}
__device__ __forceinline__ float reduce_scatter16(float (&a)[16], int lane) {
    float s8[8], t4[4], u2[2];
#pragma unroll
    for (int e = 0; e < 8; ++e) { const auto r = __builtin_amdgcn_permlane32_swap(__float_as_uint(a[e]), __float_as_uint(a[e + 8]), false, false); s8[e] = __uint_as_float(r[0]) + __uint_as_float(r[1]); }
#pragma unroll
    for (int e = 0; e < 4; ++e) { const auto r = __builtin_amdgcn_permlane16_swap(__float_as_uint(s8[e]), __float_as_uint(s8[e + 4]), false, false); t4[e] = __uint_as_float(r[0]) + __uint_as_float(r[1]); }
    const bool b3 = (lane & 8) != 0, b2 = (lane & 4) != 0;
#pragma unroll
    for (int e = 0; e < 2; ++e) { const float keep = b3 ? t4[e + 2] : t4[e], give = b3 ? t4[e] : t4[e + 2];
        u2[e] = keep + __builtin_bit_cast(float, DPP_I(__builtin_bit_cast(int, give), 0x140)); }
    const float keep = b2 ? u2[1] : u2[0], give = b2 ? u2[0] : u2[1];
    float w = keep + __builtin_bit_cast(float, DPP_I(__builtin_bit_cast(int, give), 0x141));
    w += __builtin_bit_cast(float, DPP_I(__builtin_bit_cast(int, w), 0xB1)); w += __builtin_bit_cast(float, DPP_I(__builtin_bit_cast(int, w), 0x4E));
    return w;
}
__device__ __forceinline__ float sigmoidf_(float x) { return __builtin_amdgcn_rcpf(1.0f + __expf(-x)); }
__device__ __forceinline__ float siluf_(float x) { return x * __builtin_amdgcn_rcpf(1.0f + __expf(-x)); }
__device__ __forceinline__ float gelu_tanh_(float x) {
    const float u = 1.5957691216057308f * (x + 0.044715f * x * x * x);
    return x * __builtin_amdgcn_rcpf(1.0f + __expf(-u));
}
__device__ __forceinline__ unsigned pk4_fp8(float a, float b, float c, float d) { int t = __builtin_amdgcn_cvt_pk_fp8_f32(a, b, 0, false); t = __builtin_amdgcn_cvt_pk_fp8_f32(c, d, t, true); return (unsigned)t; }
#define LDS_WAIT() asm volatile("s_waitcnt lgkmcnt(0)" ::: "memory")
#define VM_WAIT() asm volatile("s_waitcnt vmcnt(0)" ::: "memory")

#define XB_TMO      128
#define XB_XCNT(j)  (256  + 64 * (j))
#define XB_XSUB(j)  (1280 + 64 * (j))
#define XB_XGEN(j)  (2304 + 64 * (j))
#define XB_TOP      3328
#define XB_TOPGEN   3392
#define XCD_BAR_WORDS 3456
#define XB_SPIN_CAP (1u << 18)
__device__ __forceinline__ unsigned xb_ld(unsigned* p)              { return __hip_atomic_load(p, __ATOMIC_RELAXED, __HIP_MEMORY_SCOPE_AGENT); }
__device__ __forceinline__ unsigned xb_add(unsigned* p, unsigned v) { return __hip_atomic_fetch_add(p, v, __ATOMIC_RELAXED, __HIP_MEMORY_SCOPE_AGENT); }
__device__ __forceinline__ unsigned xb_xcc_id() { return (unsigned)__builtin_amdgcn_s_getreg((3 << 11) | 20) & 0xFu; }
#define XB_SPIN(cond, bar) do { unsigned _sp = 0; while (cond) { __builtin_amdgcn_s_sleep(1); \
    if ((++_sp & 255u) == 0u) { if (xb_ld(&(bar)[XB_TMO])) break; if (_sp > XB_SPIN_CAP) { atomicAdd(&(bar)[XB_TMO], 1u); break; } } } } while (0)
struct XcdBarrier { unsigned* bar; unsigned x; volatile LAS unsigned* st; };
__device__ __forceinline__ XcdBarrier xcd_barrier_post(unsigned* bar, volatile LAS unsigned* st) {
    XcdBarrier b; b.bar = bar; b.x = xb_xcc_id(); b.st = st;
    if (threadIdx.x == 0) (void)xb_add(&bar[XB_XCNT(b.x)], 1u);
    return b;
}
__device__ __forceinline__ void xcd_barrier_complete(unsigned* bar, unsigned x, unsigned& nloc, unsigned& nx) {
    const unsigned G = gridDim.x * gridDim.y * gridDim.z;
    unsigned sum, cnt, mine, sp = 0u;
    for (;;) {
        sum = 0u; cnt = 0u; mine = 0u;
#pragma unroll
        for (unsigned j = 0; j < 16; ++j) { const unsigned c = xb_ld(&bar[XB_XCNT(j)]); sum += c; cnt += (c > 0u) ? 1u : 0u; mine = (j == x) ? c : mine; }
        if (sum == G) break;
        __builtin_amdgcn_s_sleep(1);
        if ((++sp & 255u) == 0u) { if (xb_ld(&bar[XB_TMO])) break; if (sp > XB_SPIN_CAP) { atomicAdd(&bar[XB_TMO], 1u); break; } }
    }
    nloc = mine > 0u ? mine : 1u; nx = cnt > 0u ? cnt : 1u;
}
__device__ __forceinline__ void xcd_barrier(const XcdBarrier& b) {
    asm volatile("s_waitcnt vmcnt(0)" ::: "memory");
    __syncthreads();
    if (threadIdx.x == 0) {
        unsigned* bar = b.bar;
        __builtin_amdgcn_s_waitcnt(0);
        unsigned nloc = b.st[0], nx = b.st[1];
        if (nloc == 0u) { xcd_barrier_complete(bar, b.x, nloc, nx); b.st[0] = nloc; b.st[1] = nx; }
        const unsigned old = xb_add(&bar[XB_XSUB(b.x)], 1u);
        const unsigned gen = old / nloc;
        if (old + 1u == (gen + 1u) * nloc) {
            __builtin_amdgcn_fence(__ATOMIC_RELEASE, "agent");
            asm volatile("s_waitcnt vmcnt(0)" ::: "memory");
            const unsigned og = xb_add(&bar[XB_TOP], 1u);
            const unsigned tg = og / nx;
            if (og + 1u == (tg + 1u) * nx) xb_add(&bar[XB_TOPGEN], 1u);
            else XB_SPIN(xb_ld(&bar[XB_TOPGEN]) == tg, bar);
            __builtin_amdgcn_fence(__ATOMIC_ACQUIRE, "agent");
            xb_add(&bar[XB_XGEN(b.x)], 1u);
            asm volatile("s_waitcnt vmcnt(0)" ::: "memory");
        } else {
            XB_SPIN(xb_ld(&bar[XB_XGEN(b.x)]) == gen, bar);
            __builtin_amdgcn_fence(__ATOMIC_ACQUIRE, "agent");
            asm volatile("s_waitcnt vmcnt(0)" ::: "memory");
        }
    }
    __syncthreads();
}
namespace pg8 {
constexpr int BM = 256, BK = 64, HALF = 128, HTB = HALF * BK * 2, STAGE_BYTES = 8 * HTB, NXCD = 8, WGM = 8;
__host__ __device__ __forceinline__ int lds_byte(int r, int c) { const int st = (r >> 4) * 2 + (c >> 5), rr = r & 15, cc = c & 31, ob = rr * 64 + cc * 2; return st * 1024 + (ob ^ (((ob >> 9) & 1) << 5)); }
__host__ __device__ __forceinline__ void stage_rc(int b, int& R, int& C) { const int st = b / 1024, sb = b % 1024, swz = sb ^ (((sb >> 9) & 1) << 5); R = (st >> 1) * 16 + swz / 64; C = (st & 1) * 32 + (swz % 64) / 2; }
__host__ __device__ __forceinline__ int perm32(int rho) { const int n = rho >> 4, i = rho & 15; return 8 * (i >> 2) + 4 * n + (i & 3); }

struct Unit { int pm, pn, g; };
struct Gemm { const bf16_t* A; const bf16_t* Bt; int lda, ldb, K; size_t gsA, gsB; };

struct OrdDense {
    int nM, nN, nwg, G, c;
    __device__ void init(int nM_, int nN_, int G_, int c_) { nM = nM_; nN = nN_; nwg = nM * nN; G = G_; c = c_; }
    __device__ bool next(int i, Unit& u) const {
        const long L = (long)i * G + c; if (L >= nwg) return false;
        int wgid = (int)L; { const int q = nwg / NXCD, r = nwg % NXCD, xcd = wgid % NXCD, off = wgid / NXCD; wgid = (xcd < r ? xcd * (q + 1) : r * (q + 1) + (xcd - r) * q) + off; }
        const int nig = WGM * nN, gid = wgid / nig, fm = gid * WGM, gsz = (nM - fm) < WGM ? (nM - fm) : WGM;
        u.pm = fm + ((wgid % nig) % gsz); u.pn = (wgid % nig) / gsz; u.g = 0; return true;
    }
};
struct OrdGrouped {
    int ng, nM, nN, nX, G, v;
    __device__ void init(int ng_, int nM_, int nN_, int nX_, int G_, int v_) { ng = ng_; nM = nM_; nN = nN_; nX = nX_; G = G_; v = v_; }
    __device__ bool next(int i, Unit& u) const {
        const int per = nM * nN, main = ng * per; const long L = (long)i * G + v;
        if (L < main) { const int l = (int)L; u.g = l / per; const int rem = l % per; u.pn = rem % nN; u.pm = rem / nN; return true; }
        const int l2 = (int)(L - main); if (l2 >= ng * nN * nX) return false;
        u.g = l2 / nN; u.pn = l2 % nN; u.pm = nM; return true;
    }
};

template <class Epi, class Sched>
__device__ __forceinline__ void gemm_phase(LAS unsigned char* lds, const Gemm g, const Sched& S, const Epi& E) {
    const int tid = threadIdx.x, wid = __builtin_amdgcn_readfirstlane(tid >> 6), lane = tid & 63, wr = wid >> 2, wc = wid & 3, fr = lane & 15, fq = lane >> 4;
    const int K = g.K, nt = K / BK;
    unsigned voffA[2], voffB[2];
#pragma unroll
    for (int i = 0; i < 2; ++i) { int R, C; stage_rc(tid * 16 + i * 8192, R, C); const int Rb = Epi::PERM ? ((R & ~31) + perm32(R & 31)) : R;
        voffA[i] = (unsigned)(R * g.lda + C) * 2u; voffB[i] = (unsigned)(Rb * g.ldb + C) * 2u; }
    const size_t kstep = (size_t)(BK * 2);
    const size_t hsA = (size_t)HALF * g.lda * 2, hsB = (size_t)HALF * g.ldb * 2;
    const unsigned ldsw = (unsigned)wid * 1024u;
    const int aoff = lds_byte(wr * 64 + fr, fq * 8), boff = lds_byte(wc * 32 + fr, fq * 8);
#define PG8_SA(b, h) (((b) * 2 + (h)) * HTB)
#define PG8_SB(b, h) ((4 + (b) * 2 + (h)) * HTB)
#define PG8_STAGE(bufoff, gbase, voff) do { _Pragma("unroll") for (int _i = 0; _i < 2; ++_i) \
        __builtin_amdgcn_global_load_lds((const unsigned*)((const char*)(gbase) + (voff)[_i]), (LAS unsigned*)(lds + (bufoff) + ldsw + _i * 8192), 16, 0, 0); } while (0)
#define PG8_LDA(dst, b, h) do { _Pragma("unroll") for (int m = 0; m < 4; ++m) _Pragma("unroll") for (int k = 0; k < 2; ++k) dst[m][k] = *(const LAS bf16x8*)(lds + PG8_SA(b, h) + aoff + m * 2048 + k * 1024); } while (0)
#define PG8_LDB(dst, b, h) do { _Pragma("unroll") for (int n = 0; n < 2; ++n) _Pragma("unroll") for (int k = 0; k < 2; ++k) dst[n][k] = *(const LAS bf16x8*)(lds + PG8_SB(b, h) + boff + n * 2048 + k * 1024); } while (0)
#define PG8_MMA(ai, bj, At, Bt) do { __builtin_amdgcn_s_setprio(1); _Pragma("unroll") for (int m = 0; m < 4; ++m) _Pragma("unroll") for (int n = 0; n < 2; ++n) _Pragma("unroll") for (int k = 0; k < 2; ++k) \
        acc[ai][bj][m][n] = __builtin_amdgcn_mfma_f32_16x16x32_bf16(Bt[n][k], At[m][k], acc[ai][bj][m][n], 0, 0, 0); __builtin_amdgcn_s_setprio(0); } while (0)
#define PG8_WAIT_V(n) asm volatile("s_waitcnt vmcnt(" #n ")" ::: "memory")
#define PG8_WAIT_L(n) asm volatile("s_waitcnt lgkmcnt(" #n ")" ::: "memory")
#define PG8_WAIT_V8F(fresh) do { if (fresh) { if constexpr (Epi::NST == 8) PG8_WAIT_V(16); else if constexpr (Epi::NST == 16) PG8_WAIT_V(24); else PG8_WAIT_V(40); } else PG8_WAIT_V(8); } while (0)
#define PG8_BAR __builtin_amdgcn_s_barrier()
#define PG8_SCHED __builtin_amdgcn_sched_barrier(0)
#define PG8_ABASE(u) ((const char*)g.A + ((size_t)(u).g * g.gsA + (size_t)(u).pm * BM * g.lda) * 2)
#define PG8_BBASE(u) ((const char*)g.Bt + ((size_t)(u).g * g.gsB + (size_t)(u).pn * BM * g.ldb) * 2)
    Unit cur, nxt; int ui = 0;
    if (!S.next(0, cur)) return;
    f32x4 acc[2][2][4][2];
#pragma unroll
    for (int a = 0; a < 2; ++a)
#pragma unroll
        for (int b = 0; b < 2; ++b)
#pragma unroll
            for (int m = 0; m < 4; ++m)
#pragma unroll
                for (int n = 0; n < 2; ++n) acc[a][b][m][n] = (f32x4){0.f, 0.f, 0.f, 0.f};
    bf16x8 At[4][2], B0[2][2], B1[2][2];
    const char* cA = PG8_ABASE(cur); const char* cB = PG8_BBASE(cur);
    PG8_STAGE(PG8_SB(0, 0), cB, voffB); PG8_STAGE(PG8_SB(0, 1), cB + hsB, voffB); PG8_STAGE(PG8_SA(0, 0), cA, voffA); PG8_STAGE(PG8_SA(0, 1), cA + hsA, voffA);
    if (wr == 1) PG8_BAR;
    PG8_WAIT_V(2); PG8_BAR;
    PG8_STAGE(PG8_SB(1, 0), cB + kstep, voffB); PG8_STAGE(PG8_SA(1, 0), cA + kstep, voffA); PG8_STAGE(PG8_SB(1, 1), cB + hsB + kstep, voffB);
    PG8_WAIT_V(6); PG8_BAR;
    for (;;) {
        const bool has_next = S.next(ui + 1, nxt);
        const char* nA = has_next ? PG8_ABASE(nxt) : cA; const char* nB = has_next ? PG8_BBASE(nxt) : cB;
#pragma clang loop unroll(disable)
        for (int t = 0; t < nt; t += 2) {
            const bool last = (t == nt - 2); const bool fresh = (t == 0) && (ui > 0);
            const char* a1 = cA + (size_t)(t + 1) * kstep;
            const char* a2 = last ? nA : cA + (size_t)(t + 2) * kstep; const char* b2 = last ? nB : cB + (size_t)(t + 2) * kstep;
            const char* a3 = a2 + kstep; const char* b3 = b2 + kstep;
            PG8_LDB(B0, 0, 0); PG8_LDB(B1, 0, 1); PG8_SCHED; PG8_LDA(At, 0, 0); PG8_STAGE(PG8_SA(1, 1), a1 + hsA, voffA);
            PG8_WAIT_V8F(fresh); PG8_WAIT_L(0); PG8_BAR; PG8_MMA(0, 0, At, B0); PG8_MMA(0, 1, At, B1); PG8_BAR; PG8_SCHED;
            PG8_LDA(At, 0, 1); PG8_STAGE(PG8_SB(0, 0), b2, voffB); PG8_STAGE(PG8_SB(0, 1), b2 + hsB, voffB); PG8_STAGE(PG8_SA(0, 0), a2, voffA);
            PG8_WAIT_V8F(fresh); PG8_WAIT_L(0); PG8_BAR; PG8_MMA(1, 0, At, B0); PG8_MMA(1, 1, At, B1); PG8_BAR; PG8_SCHED;
            PG8_LDB(B0, 1, 0); PG8_LDB(B1, 1, 1); PG8_SCHED; PG8_LDA(At, 1, 0); PG8_STAGE(PG8_SA(0, 1), a2 + hsA, voffA);
            PG8_WAIT_V(8); PG8_WAIT_L(0); PG8_BAR; PG8_MMA(0, 0, At, B0); PG8_MMA(0, 1, At, B1); PG8_BAR; PG8_SCHED;
            PG8_LDA(At, 1, 1); PG8_STAGE(PG8_SB(1, 0), b3, voffB); PG8_STAGE(PG8_SB(1, 1), b3 + hsB, voffB); PG8_STAGE(PG8_SA(1, 0), a3, voffA);
            PG8_WAIT_V(8); PG8_WAIT_L(0); PG8_BAR; PG8_MMA(1, 0, At, B0); PG8_MMA(1, 1, At, B1); PG8_BAR; PG8_SCHED;
        }
        if (wr == 0) PG8_BAR;
        E(acc, cur, wr, wc, fr, fq);
        if (!has_next) break;
#pragma unroll
        for (int a = 0; a < 2; ++a)
#pragma unroll
            for (int b = 0; b < 2; ++b)
#pragma unroll
                for (int m = 0; m < 4; ++m)
#pragma unroll
                    for (int n = 0; n < 2; ++n) acc[a][b][m][n] = (f32x4){0.f, 0.f, 0.f, 0.f};
        cur = nxt; cA = nA; cB = nB; ++ui;
        if (wr == 1) PG8_BAR;
    }
    PG8_WAIT_V(0);
    PG8_BAR;
#undef PG8_SA
#undef PG8_SB
#undef PG8_STAGE
#undef PG8_LDA
#undef PG8_LDB
#undef PG8_MMA
#undef PG8_WAIT_V
#undef PG8_WAIT_L
#undef PG8_WAIT_V8F
#undef PG8_BAR
#undef PG8_SCHED
#undef PG8_ABASE
#undef PG8_BBASE
}

typedef int i32x8 __attribute__((ext_vector_type(8)));
typedef int i32x4 __attribute__((ext_vector_type(4)));
template <class Epi, class Sched, bool GATHER = false>
__device__ __forceinline__ void gemm_phase_f8(LAS unsigned char* lds, const Gemm g, const Sched& S, const Epi& E, const int* tok = nullptr, int tok_gs = 0, int tok_max = 0) {
    const int tid = threadIdx.x, wid = __builtin_amdgcn_readfirstlane(tid >> 6), lane = tid & 63, wr = wid >> 2, wc = wid & 3, fr = lane & 15, fq = lane >> 4;
    const int K = g.K, nt = K / 128;
    unsigned voffA[2], voffB[2]; int rowA[2]; unsigned colA[2];
#pragma unroll
    for (int i = 0; i < 2; ++i) { int R, C; stage_rc(tid * 16 + i * 8192, R, C); const int Rb = Epi::PERM ? ((R & ~31) + perm32(R & 31)) : R;
        voffA[i] = (unsigned)(R * g.lda + C * 2); voffB[i] = (unsigned)(Rb * g.ldb + C * 2); rowA[i] = R; colA[i] = (unsigned)(C * 2); }
    const size_t kstep = (size_t)(BK * 2);
    const size_t hsA = (size_t)HALF * g.lda, hsB = (size_t)HALF * g.ldb;
    const unsigned ldsw = (unsigned)wid * 1024u;
    const int aoff = lds_byte(wr * 64 + fr, fq * 8), boff = lds_byte(wc * 32 + fr, fq * 8);
#define PG8_SA(b, h) (((b) * 2 + (h)) * HTB)
#define PG8_SB(b, h) ((4 + (b) * 2 + (h)) * HTB)
#define PG8_STAGE(bufoff, gbase, voff) do { _Pragma("unroll") for (int _i = 0; _i < 2; ++_i) \
        __builtin_amdgcn_global_load_lds((const unsigned*)((const char*)(gbase) + (voff)[_i]), (LAS unsigned*)(lds + (bufoff) + ldsw + _i * 8192), 16, 0, 0); } while (0)
#define PG8_LD32(p) __builtin_shufflevector(*(const LAS i32x4*)(p), *(const LAS i32x4*)((p) + 1024), 0, 1, 2, 3, 4, 5, 6, 7)
#define PG8_LDA(dst, b, h) do { _Pragma("unroll") for (int m = 0; m < 4; ++m) dst[m] = PG8_LD32(lds + PG8_SA(b, h) + aoff + m * 2048); } while (0)
#define PG8_LDB(dst, b, h) do { _Pragma("unroll") for (int n = 0; n < 2; ++n) dst[n] = PG8_LD32(lds + PG8_SB(b, h) + boff + n * 2048); } while (0)
#define PG8_MMA(ai, bj, At, Bt) do { __builtin_amdgcn_s_setprio(1); _Pragma("unroll") for (int m = 0; m < 4; ++m) _Pragma("unroll") for (int n = 0; n < 2; ++n) \
        asm volatile("v_mfma_scale_f32_16x16x128_f8f6f4 %0, %1, %2, %0, %3, %4 op_sel_hi:[0,0,0]" : "+v"(acc[ai][bj][m][n]) : "v"(Bt[n]), "v"(At[m]), "v"(sclw), "v"(scl)); __builtin_amdgcn_s_setprio(0); } while (0)
#define PG8_WAIT_V(n) asm volatile("s_waitcnt vmcnt(" #n ")" ::: "memory")
#define PG8_WAIT_L(n) asm volatile("s_waitcnt lgkmcnt(" #n ")" ::: "memory")
#define PG8_WAIT_V8F(fresh) do { if (fresh) { if constexpr (GATHER && Epi::NST == 8) PG8_WAIT_V(20);   else if constexpr (Epi::NST == 8) PG8_WAIT_V(16); else if constexpr (Epi::NST == 16) PG8_WAIT_V(24); else PG8_WAIT_V(40); } else PG8_WAIT_V(8); } while (0)
#define PG8_BAR __builtin_amdgcn_s_barrier()
#define PG8_SCHED __builtin_amdgcn_sched_barrier(0)
#define PG8_ABASE(u) ((const char*)g.A + ((size_t)(u).g * g.gsA + (size_t)(u).pm * BM * g.lda))
#define PG8_BBASE(u) ((const char*)g.Bt + ((size_t)(u).g * g.gsB + (size_t)(u).pn * BM * g.ldb))
#define PG8_GOFF(dst, u) do { _Pragma("unroll") for (int _h = 0; _h < 2; ++_h) _Pragma("unroll") for (int _i = 0; _i < 2; ++_i) { \
        int _t = tok[(size_t)(u).g * tok_gs + (u).pm * BM + _h * HALF + rowA[_i]]; _t = ((unsigned)_t < (unsigned)tok_max) ? _t : 0; dst[_h][_i] = (unsigned)_t * (unsigned)g.lda + colA[_i]; } } while (0)
    Unit cur, nxt; int ui = 0;
    if (!S.next(0, cur)) return;
    unsigned ogc[2][2], ogn[2][2];
    if constexpr (GATHER) { PG8_GOFF(ogc, cur); _Pragma("unroll") for (int _h = 0; _h < 2; ++_h) _Pragma("unroll") for (int _i = 0; _i < 2; ++_i) ogn[_h][_i] = ogc[_h][_i]; }
    f32x4 acc[2][2][4][2];
#pragma unroll
    for (int a = 0; a < 2; ++a)
#pragma unroll
        for (int b = 0; b < 2; ++b)
#pragma unroll
            for (int m = 0; m < 4; ++m)
#pragma unroll
                for (int n = 0; n < 2; ++n) { acc[a][b][m][n] = (f32x4){0.f, 0.f, 0.f, 0.f}; asm volatile("" : "+v"(acc[a][b][m][n])); }
    i32x8 At[4], B0[2], B1[2]; int scl = 0x7f7f7f7f, sclw = 0x7a7a7a7a; asm volatile("" : "+v"(scl), "+v"(sclw));
    const char* cA = GATHER ? (const char*)g.A : PG8_ABASE(cur); const char* cB = PG8_BBASE(cur);
    const __amdgpu_buffer_rsrc_t rsA = __builtin_amdgcn_make_buffer_rsrc((void*)g.A, 0, GATHER ? tok_max * g.lda : 0, 0x00020000);
#define PG8_STAGE_BUF(bufoff, kofs, voff) do { _Pragma("unroll") for (int _i = 0; _i < 2; ++_i) \
        __builtin_amdgcn_raw_ptr_buffer_load_lds(rsA, (LAS void*)(lds + (bufoff) + ldsw + _i * 8192), 16, (int)(voff)[_i], (int)(kofs), 0, 0); } while (0)
#define PG8_STA_C(buf, p, h) do { if constexpr (GATHER) PG8_STAGE_BUF(buf, (p) - cA, ogc[h]); else PG8_STAGE(buf, (p) + (h) * hsA, voffA); } while (0)
#define PG8_STA_X(buf, p, h) do { if constexpr (GATHER) PG8_STAGE_BUF(buf, (p) - cA, ogx[h]); else PG8_STAGE(buf, (p) + (h) * hsA, voffA); } while (0)
    PG8_STAGE(PG8_SB(0, 0), cB, voffB); PG8_STAGE(PG8_SB(0, 1), cB + hsB, voffB); PG8_STA_C(PG8_SA(0, 0), cA, 0); PG8_STA_C(PG8_SA(0, 1), cA, 1);
    if (wr == 1) PG8_BAR;
    PG8_WAIT_V(2); PG8_BAR;
    PG8_STAGE(PG8_SB(1, 0), cB + kstep, voffB); PG8_STA_C(PG8_SA(1, 0), cA + kstep, 0); PG8_STAGE(PG8_SB(1, 1), cB + hsB + kstep, voffB);
    PG8_WAIT_V(6); PG8_BAR;
    for (;;) {
        const bool has_next = S.next(ui + 1, nxt);
        const char* nA = GATHER ? cA : (has_next ? PG8_ABASE(nxt) : cA); const char* nB = has_next ? PG8_BBASE(nxt) : cB;
        if constexpr (GATHER) { if (has_next) PG8_GOFF(ogn, nxt); }
#pragma clang loop unroll(disable)
        for (int t = 0; t < nt; t += 2) {
            const bool last = (t == nt - 2); const bool fresh = (t == 0) && (ui > 0);
            const char* a1 = cA + (size_t)(t + 1) * kstep;
            const char* a2 = last ? nA : cA + (size_t)(t + 2) * kstep; const char* b2 = last ? nB : cB + (size_t)(t + 2) * kstep;
            const char* a3 = a2 + kstep; const char* b3 = b2 + kstep;
            unsigned ogx[2][2];
            if constexpr (GATHER) { _Pragma("unroll") for (int _h = 0; _h < 2; ++_h) _Pragma("unroll") for (int _i = 0; _i < 2; ++_i) ogx[_h][_i] = last ? ogn[_h][_i] : ogc[_h][_i]; }
            PG8_LDB(B0, 0, 0); PG8_LDB(B1, 0, 1); PG8_SCHED; PG8_LDA(At, 0, 0); PG8_STA_C(PG8_SA(1, 1), a1, 1);
            PG8_WAIT_V8F(fresh); PG8_WAIT_L(0); PG8_BAR; PG8_MMA(0, 0, At, B0); PG8_MMA(0, 1, At, B1); PG8_BAR; PG8_SCHED;
            PG8_LDA(At, 0, 1); PG8_STAGE(PG8_SB(0, 0), b2, voffB); PG8_STAGE(PG8_SB(0, 1), b2 + hsB, voffB); PG8_STA_X(PG8_SA(0, 0), a2, 0);
            PG8_WAIT_V8F(fresh); PG8_WAIT_L(0); PG8_BAR; PG8_MMA(1, 0, At, B0); PG8_MMA(1, 1, At, B1); PG8_BAR; PG8_SCHED;
            PG8_LDB(B0, 1, 0); PG8_LDB(B1, 1, 1); PG8_SCHED; PG8_LDA(At, 1, 0); PG8_STA_X(PG8_SA(0, 1), a2, 1);
            PG8_WAIT_V(8); PG8_WAIT_L(0); PG8_BAR; PG8_MMA(0, 0, At, B0); PG8_MMA(0, 1, At, B1); PG8_BAR; PG8_SCHED;
            PG8_LDA(At, 1, 1); PG8_STAGE(PG8_SB(1, 0), b3, voffB); PG8_STAGE(PG8_SB(1, 1), b3 + hsB, voffB); PG8_STA_X(PG8_SA(1, 0), a3, 0);
            PG8_WAIT_V(8); PG8_WAIT_L(0); PG8_BAR; PG8_MMA(1, 0, At, B0); PG8_MMA(1, 1, At, B1); PG8_BAR; PG8_SCHED;
        }
        if (wr == 0) PG8_BAR;
        asm volatile("s_nop 15\n\ts_nop 15" ::: "memory");
        E(acc, cur, wr, wc, fr, fq);
        if (!has_next) break;
#pragma unroll
        for (int a = 0; a < 2; ++a)
#pragma unroll
            for (int b = 0; b < 2; ++b)
#pragma unroll
                for (int m = 0; m < 4; ++m)
#pragma unroll
                    for (int n = 0; n < 2; ++n) { acc[a][b][m][n] = (f32x4){0.f, 0.f, 0.f, 0.f}; asm volatile("" : "+v"(acc[a][b][m][n])); }
        cur = nxt; cA = nA; cB = nB; ++ui;
        if constexpr (GATHER) { _Pragma("unroll") for (int _h = 0; _h < 2; ++_h) _Pragma("unroll") for (int _i = 0; _i < 2; ++_i) ogc[_h][_i] = ogn[_h][_i]; }
        if (wr == 1) PG8_BAR;
    }
    PG8_WAIT_V(0);
    PG8_BAR;
#undef PG8_SA
#undef PG8_SB
#undef PG8_STAGE
#undef PG8_LDA
#undef PG8_LDB
#undef PG8_MMA
#undef PG8_WAIT_V
#undef PG8_WAIT_L
#undef PG8_WAIT_V8F
#undef PG8_BAR
#undef PG8_SCHED
#undef PG8_ABASE
#undef PG8_BBASE
#undef PG8_LD32
#undef PG8_GOFF
#undef PG8_STA_C
#undef PG8_STAGE_BUF
#undef PG8_STA_X
}

typedef const f32x4 (&AccRef)[2][2][4][2];

__device__ __forceinline__ u32x4 pack8(f32x4 v0, f32x4 v1) { u32x4 w; w.x = cvt_pk_bf16(v0[0], v0[1]); w.y = cvt_pk_bf16(v0[2], v0[3]); w.z = cvt_pk_bf16(v1[0], v1[1]); w.w = cvt_pk_bf16(v1[2], v1[3]); return w; }

struct EpiInProj {
    static constexpr bool PERM = true; static constexpr int NST = 16;
    bf16_t* Z; const float* ropec; const float* ropes;
    __device__ __forceinline__ void operator()(AccRef acc, const Unit& u, int wr, int wc, int fr, int fq) const {
        const int bt = u.pm / 33; const bool ctx = (u.pm - bt * 33) == 0; const bool rope = (u.pn < 4) && !ctx;
        const int row0 = u.pm * BM + wr * 64 + fr, col0 = u.pn * BM + wc * 32 + 8 * fq;
        const int tbase = row0 - bt * SP - CTXL;
#pragma unroll
        for (int ai = 0; ai < 2; ++ai)
#pragma unroll
            for (int m = 0; m < 4; ++m) {
                const int row = row0 + ai * HALF + m * 16; bf16_t* rowp = Z + (size_t)row * 2048 + col0;
                f32x4 c0 = {1.f, 1.f, 1.f, 1.f}, c1 = c0, s0 = {0.f, 0.f, 0.f, 0.f}, s1 = s0;
                if (rope) { const int t = tbase + ai * HALF + m * 16; const int pos = (wc & 1) ? (t & 63) : (t >> 6); const int o = pos * 16 + 8 * (fq & 1);
                    c0 = *(const f32x4*)(ropec + o); c1 = *(const f32x4*)(ropec + o + 4); s0 = *(const f32x4*)(ropes + o); s1 = *(const f32x4*)(ropes + o + 4);
                    if (fq < 2) { s0 = -s0; s1 = -s1; } }
#pragma unroll
                for (int bj = 0; bj < 2; ++bj) { f32x4 v0 = acc[ai][bj][m][0], v1 = acc[ai][bj][m][1];
                    if (rope) { f32x4 p0, p1;
#pragma unroll
                        for (int j = 0; j < 4; ++j) { p0[j] = __shfl_xor(v0[j], 32); p1[j] = __shfl_xor(v1[j], 32); }
                        v0 = v0 * c0 + p0 * s0; v1 = v1 * c1 + p1 * s1; }
                    *(u32x4*)(rowp + bj * HALF) = pack8(v0, v1); } }
    }
};
struct EpiResid {
    static constexpr bool PERM = false; static constexpr int NST = 32;
    const float* xin_lat; const float* xin_ctx; bf16_t* hb; const float* mod; int tokmode;
    __device__ __forceinline__ void operator()(AccRef acc, const Unit& u, int wr, int wc, int fr, int fq) const {
        const float* xin = nullptr; const float* gate; int rl0, rt0;
        if (tokmode) { const int bt = u.pm / 33, pt = u.pm - bt * 33; rt0 = u.pm * BM;
            if (pt == 0) { xin = xin_ctx; gate = mod + 4 * 6144 + 2048; rl0 = bt * CTXL; }
            else { xin = xin_lat; gate = mod + bt * 6144 + 2048; rl0 = bt * SEQ + (pt - 1) * BM; } }
        else { const int bt = u.pm / 32; gate = mod + bt * 6144 + 2048; rl0 = 0; rt0 = bt * SP + CTXL + (u.pm - bt * 32) * BM; }
        const int col0 = u.pn * BM + wc * 32 + 4 * fq;
        f32x4 gv[2][2];
#pragma unroll
        for (int bj = 0; bj < 2; ++bj)
#pragma unroll
            for (int n = 0; n < 2; ++n) gv[bj][n] = *(const f32x4*)(gate + col0 + bj * HALF + n * 16);
#pragma unroll
        for (int ai = 0; ai < 2; ++ai)
#pragma unroll
            for (int m = 0; m < 4; ++m) { const int rr = wr * 64 + fr + ai * HALF + m * 16; const size_t offx = (size_t)(rl0 + rr) * DM + col0; bf16_t* hp = hb + (size_t)(rt0 + rr) * DM + col0;
#pragma unroll
                for (int bj = 0; bj < 2; ++bj)
#pragma unroll
                    for (int n = 0; n < 2; ++n) { f32x4 hv;
                        if (tokmode) hv = *(const f32x4*)(xin + offx + bj * HALF + n * 16);
                        else { const u32x2 w = *(const u32x2*)(hp + bj * HALF + n * 16); hv = (f32x4){bflo(w.x), bfhi(w.x), bflo(w.y), bfhi(w.y)}; }
                        const f32x4 o = hv + gv[bj][n] * acc[ai][bj][m][n];
                        u32x2 wo; wo.x = cvt_pk_bf16(o.x, o.y); wo.y = cvt_pk_bf16(o.z, o.w); *(u32x2*)(hp + bj * HALF + n * 16) = wo; }
                asm volatile("" ::: "memory"); }
    }
};
struct EpiGateUp {
    static constexpr bool PERM = true; static constexpr int NST = 8;
    unsigned char* H; float sc;
    __device__ __forceinline__ void operator()(AccRef acc, const Unit& u, int wr, int wc, int fr, int fq) const {
        const int row0 = u.pm * BM + wr * 64 + fr, col0 = u.pn * HALF + wc * 32 + 8 * fq;
        unsigned char* base = H + (size_t)u.g * XROWS * EHID;
#pragma unroll
        for (int ai = 0; ai < 2; ++ai)
#pragma unroll
            for (int m = 0; m < 4; ++m) { f32x4 o0, o1;
#pragma unroll
                for (int j = 0; j < 4; ++j) { o0[j] = siluf_(acc[ai][0][m][0][j] * sc) * (acc[ai][1][m][0][j] * sc); o1[j] = siluf_(acc[ai][0][m][1][j] * sc) * (acc[ai][1][m][1][j] * sc); }
                u32x2 w; w.x = pk4_fp8(o0[0], o0[1], o0[2], o0[3]); w.y = pk4_fp8(o1[0], o1[1], o1[2], o1[3]);
                *(u32x2*)(base + (size_t)(row0 + ai * HALF + m * 16) * EHID + col0) = w; }
    }
};
struct EpiBf16 {
    static constexpr bool PERM = true; static constexpr int NST = 16;
    bf16_t* O; int ldc; size_t gsO; float sc;
    __device__ __forceinline__ void operator()(AccRef acc, const Unit& u, int wr, int wc, int fr, int fq) const {
        const int row0 = u.pm * BM + wr * 64 + fr, col0 = u.pn * BM + wc * 32 + 8 * fq;
        bf16_t* base = O + (size_t)u.g * gsO;
#pragma unroll
        for (int ai = 0; ai < 2; ++ai)
#pragma unroll
            for (int m = 0; m < 4; ++m) { bf16_t* rowp = base + (size_t)(row0 + ai * HALF + m * 16) * ldc + col0;
#pragma unroll
                for (int bj = 0; bj < 2; ++bj) *(u32x4*)(rowp + bj * HALF) = pack8(acc[ai][bj][m][0] * sc, acc[ai][bj][m][1] * sc); }
    }
};
constexpr float YS_SCALE = 16.f;
struct EpiF8Out {
    static constexpr bool PERM = true; static constexpr int NST = 16;
    unsigned char* O; int ldc; size_t gsO;
    __device__ __forceinline__ void operator()(AccRef acc, const Unit& u, int wr, int wc, int fr, int fq) const {
        const int row0 = u.pm * BM + wr * 64 + fr, col0 = u.pn * BM + wc * 32 + 8 * fq;
        unsigned char* base = O + (size_t)u.g * gsO;
#pragma unroll
        for (int ai = 0; ai < 2; ++ai)
#pragma unroll
            for (int m = 0; m < 4; ++m) { unsigned char* rowp = base + (size_t)(row0 + ai * HALF + m * 16) * ldc + col0;
#pragma unroll
                for (int bj = 0; bj < 2; ++bj) { const f32x4 a0 = acc[ai][bj][m][0] * YS_SCALE, a1 = acc[ai][bj][m][1] * YS_SCALE;
                    u32x2 w; w.x = pk4_fp8(a0[0], a0[1], a0[2], a0[3]); w.y = pk4_fp8(a1[0], a1[1], a1[2], a1[3]); *(u32x2*)(rowp + bj * HALF) = w; } }
    }
};
struct EpiF32 {
    static constexpr bool PERM = false; static constexpr int NST = 32;
    float* C; int ldc; size_t gsC;
    __device__ __forceinline__ void operator()(AccRef acc, const Unit& u, int wr, int wc, int fr, int fq) const {
        const int row0 = u.pm * BM + wr * 64 + fr, col0 = u.pn * BM + wc * 32 + 4 * fq;
        float* base = C + (size_t)u.g * gsC;
#pragma unroll
        for (int ai = 0; ai < 2; ++ai)
#pragma unroll
            for (int m = 0; m < 4; ++m) { float* rowp = base + (size_t)(row0 + ai * HALF + m * 16) * ldc + col0;
#pragma unroll
                for (int bj = 0; bj < 2; ++bj)
#pragma unroll
                    for (int n = 0; n < 2; ++n) *(f32x4*)(rowp + bj * HALF + n * 16) = acc[ai][bj][m][n]; }
    }
};
struct EpiSsmIn {
    static constexpr bool PERM = true; static constexpr int NST = 16;
    bf16_t* U;
    __device__ __forceinline__ void operator()(AccRef acc, const Unit& u, int wr, int wc, int fr, int fq) const {
        const int bt = u.pm / 33, pt = u.pm - bt * 33;
        const int rin0 = wr * 64 + fr;
        const int urow_base = (pt == 0) ? (1024 + bt * NCHC) : (bt * NCHL + (pt - 1) * (BM / SL));
        const int gb = 16 * u.pn + 2 * wc + (fq >> 1), ch0 = 8 * (fq & 1);
#pragma unroll
        for (int ai = 0; ai < 2; ++ai)
#pragma unroll
            for (int m = 0; m < 4; ++m) { const int rin = rin0 + ai * HALF + m * 16; const int urow = urow_base + (rin >> 5), tl = rin & 31;
#pragma unroll
                for (int bj = 0; bj < 2; ++bj) { const int g = gb + 8 * bj;
                    *(u32x4*)(U + ((size_t)g * UROWS + urow) * UK + tl * 16 + ch0) = pack8(acc[ai][bj][m][0], acc[ai][bj][m][1]); } }
    }
};
struct EpiSsmY {
    static constexpr bool PERM = true; static constexpr int NST = 16;
    bf16_t* ZG;
    __device__ __forceinline__ void operator()(AccRef acc, const Unit& u, int wr, int wc, int fr, int fq) const {
        const int row0 = u.pm * BM + wr * 64 + fr;
        const int tl0 = 16 * u.pn + 2 * wc + (fq >> 1), ch0 = 8 * (fq & 1);
#pragma unroll
        for (int ai = 0; ai < 2; ++ai)
#pragma unroll
            for (int m = 0; m < 4; ++m) { const int crow = row0 + ai * HALF + m * 16;
#pragma unroll
                for (int bj = 0; bj < 2; ++bj) { const int tl = tl0 + 8 * bj; f32x4 o0, o1;
#pragma unroll
                    for (int j = 0; j < 4; ++j) { o0[j] = gelu_tanh_(acc[ai][bj][m][0][j]); o1[j] = gelu_tanh_(acc[ai][bj][m][1][j]); }
                    *(u32x4*)(ZG + ((size_t)crow * SL + tl) * DM + u.g * 16 + ch0) = pack8(o0, o1); } }
    }
};
struct EpiGlu {
    static constexpr bool PERM = true; static constexpr int NST = 16;
    const bf16_t* ZG; bf16_t* ZZ;
    __device__ __forceinline__ void operator()(AccRef acc, const Unit& u, int wr, int wc, int fr, int fq) const {
        const int row0 = u.pm * BM + wr * 64 + fr, col0 = u.pn * BM + wc * 32 + 8 * fq;
#pragma unroll
        for (int ai = 0; ai < 2; ++ai)
#pragma unroll
            for (int m = 0; m < 4; ++m) { const size_t off = (size_t)(row0 + ai * HALF + m * 16) * DM + col0;
#pragma unroll
                for (int bj = 0; bj < 2; ++bj) { const u32x4 z = *(const u32x4*)(ZG + off + bj * HALF); const f32x4 a0 = acc[ai][bj][m][0], a1 = acc[ai][bj][m][1]; f32x4 o0, o1;
                    o0[0] = bflo(z.x) * sigmoidf_(a0[0]); o0[1] = bfhi(z.x) * sigmoidf_(a0[1]); o0[2] = bflo(z.y) * sigmoidf_(a0[2]); o0[3] = bfhi(z.y) * sigmoidf_(a0[3]);
                    o1[0] = bflo(z.z) * sigmoidf_(a1[0]); o1[1] = bfhi(z.z) * sigmoidf_(a1[1]); o1[2] = bflo(z.w) * sigmoidf_(a1[2]); o1[3] = bfhi(z.w) * sigmoidf_(a1[3]);
                    *(u32x4*)(ZZ + off + bj * HALF) = pack8(o0, o1); } }
    }
};
}
namespace dattn {
constexpr int KVBLK = 64, LDZ = 2048;
constexpr float SCALE = 0.125f, THR = 8.f;
constexpr int SHM_V = KVBLK * 128 * 2, SHM_K = KVBLK * 128 * 2, SHM_ATTN = 2 * SHM_V + 2 * SHM_K + 8 * 64 * 4;
#define KSWZ(row, colB) ((row) * 256 + ((colB) ^ (((row) & 7) << 4)))
#define SBAR() __builtin_amdgcn_sched_barrier(0)
__device__ __forceinline__ int crow(int r, int hi) { return (r & 3) + 8 * (r >> 2) + 4 * hi; }
__device__ __forceinline__ float vadd(float a, float b) { float r = a + b; asm("" : "+v"(r)); return r; }
__device__ __forceinline__ void partialSM(f32x16& p0, f32x16& p1, float& m_reg, float& mn, float& alpha) {
  constexpr float C = SCALE * 1.4426950408889634f;
  float c0 = fmaxf(fmaxf(p0[0], p0[1]), p0[2]), c1 = fmaxf(fmaxf(p0[8], p0[9]), p0[10]), c2 = fmaxf(fmaxf(p1[0], p1[1]), p1[2]), c3 = fmaxf(fmaxf(p1[8], p1[9]), p1[10]);
  c0 = fmaxf(fmaxf(c0, p0[3]), p0[4]); c1 = fmaxf(fmaxf(c1, p0[11]), p0[12]); c2 = fmaxf(fmaxf(c2, p1[3]), p1[4]); c3 = fmaxf(fmaxf(c3, p1[11]), p1[12]);
  c0 = fmaxf(fmaxf(c0, p0[5]), p0[6]); c1 = fmaxf(fmaxf(c1, p0[13]), p0[14]); c2 = fmaxf(fmaxf(c2, p1[5]), p1[6]); c3 = fmaxf(fmaxf(c3, p1[13]), p1[14]);
  c0 = fmaxf(fmaxf(c0, p0[7]), c1); c2 = fmaxf(fmaxf(c2, p1[7]), c3); c0 = fmaxf(fmaxf(c0, p0[15]), p1[15]);
  float pmax = fmaxf(c0, c2);
  { auto rr = __builtin_amdgcn_permlane32_swap(__float_as_uint(pmax), __float_as_uint(pmax), false, false);
    pmax = fmaxf(__uint_as_float(rr[0]), __uint_as_float(rr[1])); }
  if (__builtin_expect(__all(pmax - m_reg <= THR / SCALE), 1)) { mn = m_reg; alpha = 1.f; }
  else { mn = fmaxf(m_reg, pmax); alpha = __builtin_amdgcn_exp2f((m_reg - mn) * C); m_reg = mn; }
  float mnC = -mn * C;
#pragma unroll
  for (int r = 0; r < 16; ++r) p0[r] = fmaf(p0[r], C, mnC);
#pragma unroll
  for (int r = 0; r < 16; ++r) p1[r] = fmaf(p1[r], C, mnC);
#pragma unroll
  for (int r = 0; r < 16; ++r) p0[r] = __builtin_amdgcn_exp2f(p0[r]);
}
__device__ __forceinline__ void finishSM(f32x16& p0, f32x16& p1, float alpha, float& l_reg, bf16x8& pa0, bf16x8& pa1, bf16x8& pa2, bf16x8& pa3) {
#pragma unroll
  for (int r = 0; r < 16; ++r) p1[r] = __builtin_amdgcn_exp2f(p1[r]);
  float s0 = vadd(p0[0], p0[1]), s1 = vadd(p0[8], p0[9]), s2 = vadd(p1[0], p1[1]), s3 = vadd(p1[8], p1[9]);
#pragma unroll
  for (int r = 2; r < 8; ++r) { s0 = vadd(s0, p0[r]); s1 = vadd(s1, p0[8 + r]); s2 = vadd(s2, p1[r]); s3 = vadd(s3, p1[8 + r]); }
  float ps = vadd(vadd(s0, s1), vadd(s2, s3));
  { auto rr = __builtin_amdgcn_permlane32_swap(__float_as_uint(ps), __float_as_uint(ps), false, false);
    ps = __uint_as_float(rr[0]) + __uint_as_float(rr[1]); }
  l_reg = l_reg * alpha + ps;
#define PK4(P, BASE, OUT) do { unsigned a0 = cvt_pk_bf16(P[BASE + 0], P[BASE + 1]), a1 = cvt_pk_bf16(P[BASE + 2], P[BASE + 3]);   \
    unsigned b0 = cvt_pk_bf16(P[BASE + 4], P[BASE + 5]), b1 = cvt_pk_bf16(P[BASE + 6], P[BASE + 7]);                              \
    auto r0 = __builtin_amdgcn_permlane32_swap(a0, b0, false, false); auto r1 = __builtin_amdgcn_permlane32_swap(a1, b1, false, false); \
    u32x4 w = {r0[0], r1[0], r0[1], r1[1]}; OUT = *reinterpret_cast<bf16x8*>(&w); } while (0)
  PK4(p0, 0, pa0); PK4(p0, 8, pa1); PK4(p1, 0, pa2); PK4(p1, 8, pa3);
#undef PK4
}
__device__ __forceinline__ void qkt(f32x16& p0, f32x16& p1, const char* Ks, const bf16x8* qr, int r32, int hi, int cmapB) {
  p0 = f32x16{}; p1 = f32x16{};
#pragma unroll
  for (int d0 = 0; d0 < 4; ++d0) { int cb = cmapB + (d0 * 16 + hi * 8) * 2;
    bf16x8 b0 = *reinterpret_cast<const bf16x8*>(Ks + KSWZ(r32, cb));
    bf16x8 b1 = *reinterpret_cast<const bf16x8*>(Ks + KSWZ(32 + r32, cb));
    p0 = __builtin_amdgcn_mfma_f32_32x32x16_bf16(b0, qr[d0], p0, 0, 0, 0);
    p1 = __builtin_amdgcn_mfma_f32_32x32x16_bf16(b1, qr[d0], p1, 0, 0, 0); }
}
__device__ __forceinline__ int v_st(int k, int c) { const int kk = (k & ~0xC) | ((k & 4) << 1) | ((k & 8) >> 1); return ((kk >> 3) * 4 + (c >> 5)) * 512 + ((kk & 7) * 32 + (c & 31)) * 2; }
__device__ __forceinline__ int v_rd_base(int lane) { return ((lane & 3) << 3) | (((lane >> 2) & 3) << 6) | (((lane >> 4) & 1) << 5) | (((lane >> 5) & 1) << 8); }
constexpr int v_rd_off(int d0, int ks, int half) { return d0 * 512 + ks * 4096 + half * 2048; }
typedef s16x4 LAS* lds_s16x4_ptr;
template <int OFF> __device__ __forceinline__ s16x4 tr_read(const LAS char* vb) {
  return __builtin_amdgcn_ds_read_tr16_b64_v4i16((lds_s16x4_ptr)(vb + OFF));
}
template <int D0> __device__ __forceinline__ void pv_one(f32x16& od, const LAS char* vb, bf16x8 pa0, bf16x8 pa1, bf16x8 pa2, bf16x8 pa3) {
  const s16x4 l0 = tr_read<v_rd_off(D0, 0, 0)>(vb), h0 = tr_read<v_rd_off(D0, 0, 1)>(vb), l1 = tr_read<v_rd_off(D0, 1, 0)>(vb), h1 = tr_read<v_rd_off(D0, 1, 1)>(vb);
  const s16x4 l2 = tr_read<v_rd_off(D0, 2, 0)>(vb), h2 = tr_read<v_rd_off(D0, 2, 1)>(vb), l3 = tr_read<v_rd_off(D0, 3, 0)>(vb), h3 = tr_read<v_rd_off(D0, 3, 1)>(vb);
#define PK(L, H) (bf16x8){L[0], L[1], L[2], L[3], H[0], H[1], H[2], H[3]}
  od = __builtin_amdgcn_mfma_f32_32x32x16_bf16(pa0, PK(l0, h0), od, 0, 0, 0);
  od = __builtin_amdgcn_mfma_f32_32x32x16_bf16(pa1, PK(l1, h1), od, 0, 0, 0);
  od = __builtin_amdgcn_mfma_f32_32x32x16_bf16(pa2, PK(l2, h2), od, 0, 0, 0);
  od = __builtin_amdgcn_mfma_f32_32x32x16_bf16(pa3, PK(l3, h3), od, 0, 0, 0);
#undef PK
}
__device__ __forceinline__ void pv_d0(f32x16* o, const LAS char* vb, bf16x8 pa0, bf16x8 pa1, bf16x8 pa2, bf16x8 pa3) {
  pv_one<0>(o[0], vb, pa0, pa1, pa2, pa3); pv_one<1>(o[1], vb, pa0, pa1, pa2, pa3); pv_one<2>(o[2], vb, pa0, pa1, pa2, pa3); pv_one<3>(o[3], vb, pa0, pa1, pa2, pa3);
}
__device__ __forceinline__ void diff_attn_unit(const bf16_t* __restrict__ Zb, int qrow0, int h, int nkeys, bf16_t* __restrict__ Y1b, float lam, const float* __restrict__ subg, char* lds) {
  const int tid = threadIdx.x, wid = tid >> 6, lane = tid & 63, r32 = lane & 31, hi = lane >> 5;
  const int map = wid >> 2, qw = wid & 3;
  char* V_lds = lds; char* K_lds = lds + 2 * SHM_V;
  float* wsl = (float*)(lds + 2 * SHM_V + 2 * SHM_K) + wid * 64; float* li_l = wsl; float* al_l = wsl + 32;
  float m_reg = -1e30f, l_reg = 0; f32x16 o[4] = {}; bf16x8 qr[4];
  const bf16_t* Qw = Zb + (size_t)(qrow0 + qw * 32 + r32) * LDZ + h * 128 + map * 64 + hi * 8;
#pragma unroll
  for (int d0 = 0; d0 < 4; ++d0) qr[d0] = *reinterpret_cast<const bf16x8*>(Qw + d0 * 16);
  const bf16_t* Kh = Zb + 512 + h * 128; const bf16_t* Vh = Zb + 1024 + h * 128;
  const int sr = tid >> 4, sc = (tid & 15) * 8, vst0 = v_st(sr, sc), kst0 = KSWZ(sr, sc * 2);
  const LAS char* vb0 = (const LAS char*)V_lds + v_rd_base(lane);
  const int cmapB = map * 128;
  struct { bf16x8 vs0, vs1, ks0, ks1; } sr_[1];
#define SLOAD(i, k0) do { sr_[i].vs0 = *reinterpret_cast<const bf16x8*>(&Vh[(size_t)((k0) + sr) * LDZ + sc]); sr_[i].vs1 = *reinterpret_cast<const bf16x8*>(&Vh[(size_t)((k0) + 32 + sr) * LDZ + sc]); \
    sr_[i].ks0 = *reinterpret_cast<const bf16x8*>(&Kh[(size_t)((k0) + sr) * LDZ + sc]); sr_[i].ks1 = *reinterpret_cast<const bf16x8*>(&Kh[(size_t)((k0) + 32 + sr) * LDZ + sc]); } while (0)
#define SWRITE(b, i) do { *(bf16x8*)(V_lds + (b) * SHM_V + vst0) = sr_[i].vs0;          \
    *(bf16x8*)(V_lds + (b) * SHM_V + vst0 + 8192) = sr_[i].vs1;               \
    *(bf16x8*)(K_lds + (b) * SHM_K + kst0) = sr_[i].ks0;                       \
    *(bf16x8*)(K_lds + (b) * SHM_K + kst0 + 8192) = sr_[i].ks1; } while (0)
#define SWAIT() asm volatile("s_waitcnt vmcnt(0)" ::: "memory")
#define RESC(a) do { if (__any((a) < 1.f)) { if (hi == 0) al_l[r32] = (a); asm volatile("s_waitcnt lgkmcnt(0)" ::: "memory"); \
    _Pragma("unroll") for (int d = 0; d < 4; ++d) _Pragma("unroll") for (int r = 0; r < 16; ++r) o[d][r] *= al_l[crow(r, hi)]; } } while (0)
  f32x16 pA0, pA1, pB0, pB1; float mnA, mnB, alA, alB; bf16x8 pa0, pa1, pa2, pa3; const int NT = nkeys / KVBLK;
  constexpr int SE = 0, SO = 0;
  SLOAD(SE, 0); asm volatile("s_waitcnt vmcnt(0)" ::: "memory"); SWRITE(0, SE); __syncthreads();
  qkt(pA0, pA1, K_lds, qr, r32, hi, cmapB); partialSM(pA0, pA1, m_reg, mnA, alA);
  SLOAD(SO, KVBLK);
  SWAIT(); SWRITE(1, SO); __syncthreads();
  for (int j = 1; j + 1 < NT; j += 2) {
    SBAR(); qkt(pB0, pB1, K_lds + SHM_K, qr, r32, hi, cmapB);
    finishSM(pA0, pA1, alA, l_reg, pa0, pa1, pa2, pa3); SBAR();
    SLOAD(SO, (j + 1) * KVBLK); SBAR();
    pv_d0(o, vb0, pa0, pa1, pa2, pa3); partialSM(pB0, pB1, m_reg, mnB, alB);
    __syncthreads(); SWAIT(); SWRITE(0, SE);
    RESC(alB); __syncthreads();
    SBAR(); qkt(pA0, pA1, K_lds, qr, r32, hi, cmapB);
    finishSM(pB0, pB1, alB, l_reg, pa0, pa1, pa2, pa3); SBAR();
    SLOAD(SE, (j + 2) * KVBLK); SBAR();
    pv_d0(o, vb0 + SHM_V, pa0, pa1, pa2, pa3); partialSM(pA0, pA1, m_reg, mnA, alA);
    __syncthreads(); SWAIT(); SWRITE(1, SO);
    RESC(alA); __syncthreads();
  }
  SBAR(); qkt(pB0, pB1, K_lds + SHM_K, qr, r32, hi, cmapB);
  finishSM(pA0, pA1, alA, l_reg, pa0, pa1, pa2, pa3); SBAR();
  pv_d0(o, vb0, pa0, pa1, pa2, pa3); partialSM(pB0, pB1, m_reg, mnB, alB);
  __syncthreads(); RESC(alB);
  finishSM(pB0, pB1, alB, l_reg, pa0, pa1, pa2, pa3); SBAR();
  pv_d0(o, vb0 + SHM_V, pa0, pa1, pa2, pa3);
  if (hi == 0) li_l[r32] = l_reg; asm volatile("s_waitcnt lgkmcnt(0)" ::: "memory");
  float rli[16];
#pragma unroll
  for (int r = 0; r < 16; ++r) rli[r] = __builtin_amdgcn_rcpf(li_l[crow(r, hi)]);
  __syncthreads();
  float* X = (float*)lds + qw * (32 * 128);
  if (map == 1) {
#pragma unroll
    for (int d0 = 0; d0 < 4; ++d0)
#pragma unroll
      for (int r = 0; r < 16; ++r) X[crow(r, hi) * 128 + d0 * 32 + r32] = o[d0][r] * rli[r] * lam;
  }
  __syncthreads();
  if (map == 0) {
    float ss[16];
#pragma unroll
    for (int r = 0; r < 16; ++r) ss[r] = 0.f;
#pragma unroll
    for (int d0 = 0; d0 < 4; ++d0)
#pragma unroll
      for (int r = 0; r < 16; ++r) { const float v = o[d0][r] * rli[r] - X[crow(r, hi) * 128 + d0 * 32 + r32]; o[d0][r] = v; ss[r] += v * v; }
#pragma unroll
    for (int r = 0; r < 16; ++r) {
      ss[r] = half32_sum(ss[r]);
      ss[r] = 0.8f * __builtin_amdgcn_rsqf(ss[r] * (1.0f / 128.0f) + EPSN); }
    int r32e = r32; asm volatile("" : "+v"(r32e));
    float gv[4];
#pragma unroll
    for (int d0 = 0; d0 < 4; ++d0) gv[d0] = subg[d0 * 32 + r32e];
    bf16_t* Ow = Y1b + (size_t)(qrow0 + qw * 32) * DM + h * 128 + r32e;
#pragma unroll
    for (int r = 0; r < 16; ++r) { const int orow = crow(r, hi);
#pragma unroll
      for (int d0 = 0; d0 < 4; ++d0) { const unsigned w = cvt_pk_bf16(o[d0][r] * ss[r] * gv[d0], 0.f); Ow[(size_t)orow * DM + d0 * 32] = (bf16_t)(w & 0xffffu); } }
  }
  __syncthreads();
#undef SLOAD
#undef SWRITE
#undef SWAIT
#undef RESC
}


struct CvtState { int next, cur, np, tick; };
struct CvtCtx { const float* wg; const float* wu; const float* wd; unsigned char* GU; unsigned char* DN; int gw, ngw, nitems; };
__device__ __forceinline__ void cvt_decode(const CvtCtx& C, int r, const float*& src, int& ldw, unsigned char*& dst, int& ldd) {
  const int le = r / 3072, q3 = r - le * 3072, which = q3 >> 10, q = q3 & 1023;
  if (which < 2) { const int kb = q >> 6, nb = q & 63, n0 = nb * 32; src = (which == 0 ? C.wg : C.wu) + (size_t)le * 1024 * 2048 + (size_t)(kb * 64) * 2048 + n0; ldw = 2048;
    dst = C.GU + (size_t)le * 4096 * 1024 + (size_t)((n0 >> 7) * 256 + which * 128 + (n0 & 127)) * 1024 + kb * 64; ldd = 1024; }
  else { const int kb = q >> 5, nb = q & 31; src = C.wd + (size_t)le * 2048 * 1024 + (size_t)(kb * 64) * 1024 + nb * 32; ldw = 1024;
    dst = C.DN + (size_t)le * 1024 * 2048 + (size_t)(nb * 32) * 2048 + kb * 64; ldd = 2048; }
}
__device__ __forceinline__ void cvt_issue(const CvtCtx& C, int r, LAS char* scr, int lane, int j0, int j1) {
  const float* src; int ldw; unsigned char* dst; int ldd; cvt_decode(C, r, src, ldw, dst, ldd);
  const __amdgpu_buffer_rsrc_t rs = __builtin_amdgcn_make_buffer_rsrc((void*)src, 0, 64 * 2048 * 4, 0x00020000);
  const int vo = ((lane >> 3) * ldw + (lane & 7) * 4) * 4;
  for (int j = j0; j < j1; ++j) __builtin_amdgcn_raw_ptr_buffer_load_lds(rs, (LAS void*)(scr + j * 1024), 16, vo, j * 8 * ldw * 4, 0, 2);
}
__device__ __forceinline__ void cvt_finish(const CvtCtx& C, int r, const LAS char* scr, int lane) {
  const float* src; int ldw; unsigned char* dst; int ldd; cvt_decode(C, r, src, ldw, dst, ldd);
  const int kq = lane >> 3, ng = lane & 7; const LAS float* s = (const LAS float*)scr + (8 * kq) * 32 + ng * 4;
  f32x4 v[8];
#pragma unroll
  for (int i = 0; i < 8; ++i) { v[i] = *(const LAS f32x4*)(s + i * 32); v[i] *= 32.f; }
  unsigned char* d = dst + (size_t)(4 * ng) * ldd + 8 * kq;
#pragma unroll
  for (int j = 0; j < 4; ++j) { u32x2 o; o.x = pk4_fp8(v[0][j], v[1][j], v[2][j], v[3][j]); o.y = pk4_fp8(v[4][j], v[5][j], v[6][j], v[7][j]); *(u32x2*)(d + (size_t)j * ldd) = o; }
}
__device__ __forceinline__ void cvt_wave_step(const CvtCtx& C, CvtState& S, LAS char* scr, int lane, int ph) {
  if (ph == 0) { if (S.cur < 0) { const int r = C.gw + S.next * C.ngw; if (r < C.nitems) { S.cur = r; S.np = 8; ++S.next; cvt_issue(C, r, scr, lane, 0, 8); } } }
  else if (ph == 3) { if (S.cur >= 0) { asm volatile("s_waitcnt vmcnt(0)" ::: "memory"); cvt_finish(C, S.cur, scr, lane); S.cur = -1; asm volatile("s_waitcnt lgkmcnt(0)" ::: "memory"); } }
}
__device__ __forceinline__ void cvt_drain(const CvtCtx& C, CvtState& S, LAS char* scr, int lane) {
  asm volatile("s_waitcnt vmcnt(0)" ::: "memory");
  for (;;) {
    if (S.cur >= 0) { if (S.np < 8) { cvt_issue(C, S.cur, scr, lane, S.np, 8); S.np = 8; asm volatile("s_waitcnt vmcnt(0)" ::: "memory"); }
      cvt_finish(C, S.cur, scr, lane); S.cur = -1; asm volatile("s_waitcnt lgkmcnt(0)" ::: "memory"); }
    const int r = C.gw + S.next * C.ngw; if (r >= C.nitems) break;
    S.cur = r; S.np = 0; ++S.next;
  }
}
__device__ __forceinline__ void softmax_full(f32x16& p0, f32x16& p1, float& m_reg, float& l_reg, float& alpha, bf16x8& pa0, bf16x8& pa1, bf16x8& pa2, bf16x8& pa3) {
  constexpr float C = SCALE * 1.4426950408889634f;
  float c0 = fmaxf(fmaxf(p0[0], p0[1]), p0[2]), c1 = fmaxf(fmaxf(p0[8], p0[9]), p0[10]), c2 = fmaxf(fmaxf(p1[0], p1[1]), p1[2]), c3 = fmaxf(fmaxf(p1[8], p1[9]), p1[10]);
  c0 = fmaxf(fmaxf(c0, p0[3]), p0[4]); c1 = fmaxf(fmaxf(c1, p0[11]), p0[12]); c2 = fmaxf(fmaxf(c2, p1[3]), p1[4]); c3 = fmaxf(fmaxf(c3, p1[11]), p1[12]);
  c0 = fmaxf(fmaxf(c0, p0[5]), p0[6]); c1 = fmaxf(fmaxf(c1, p0[13]), p0[14]); c2 = fmaxf(fmaxf(c2, p1[5]), p1[6]); c3 = fmaxf(fmaxf(c3, p1[13]), p1[14]);
  c0 = fmaxf(fmaxf(c0, p0[7]), c1); c2 = fmaxf(fmaxf(c2, p1[7]), c3); c0 = fmaxf(fmaxf(c0, p0[15]), p1[15]);
  float pmax = fmaxf(c0, c2);
  { auto rr = __builtin_amdgcn_permlane32_swap(__float_as_uint(pmax), __float_as_uint(pmax), false, false);
    pmax = fmaxf(__uint_as_float(rr[0]), __uint_as_float(rr[1])); }
  float mn;
  if (__builtin_expect(__all(pmax - m_reg <= THR / SCALE), 1)) { mn = m_reg; alpha = 1.f; }
  else { mn = fmaxf(m_reg, pmax); alpha = __builtin_amdgcn_exp2f((m_reg - mn) * C); m_reg = mn; }
  const float mnC = -mn * C;
#pragma unroll
  for (int r = 0; r < 16; ++r) p0[r] = __builtin_amdgcn_exp2f(fmaf(p0[r], C, mnC));
#pragma unroll
  for (int r = 0; r < 16; ++r) p1[r] = __builtin_amdgcn_exp2f(fmaf(p1[r], C, mnC));
  float s0 = vadd(p0[0], p0[1]), s1 = vadd(p0[8], p0[9]), s2 = vadd(p1[0], p1[1]), s3 = vadd(p1[8], p1[9]);
#pragma unroll
  for (int r = 2; r < 8; ++r) { s0 = vadd(s0, p0[r]); s1 = vadd(s1, p0[8 + r]); s2 = vadd(s2, p1[r]); s3 = vadd(s3, p1[8 + r]); }
  float ps = vadd(vadd(s0, s1), vadd(s2, s3));
  { auto rr = __builtin_amdgcn_permlane32_swap(__float_as_uint(ps), __float_as_uint(ps), false, false);
    ps = __uint_as_float(rr[0]) + __uint_as_float(rr[1]); }
  l_reg = l_reg * alpha + ps;
#define PK4(P, BASE, OUT) do { unsigned a0 = cvt_pk_bf16(P[BASE + 0], P[BASE + 1]), a1 = cvt_pk_bf16(P[BASE + 2], P[BASE + 3]);   \
    unsigned b0 = cvt_pk_bf16(P[BASE + 4], P[BASE + 5]), b1 = cvt_pk_bf16(P[BASE + 6], P[BASE + 7]);                              \
    auto r0 = __builtin_amdgcn_permlane32_swap(a0, b0, false, false); auto r1 = __builtin_amdgcn_permlane32_swap(a1, b1, false, false); \
    u32x4 w = {r0[0], r1[0], r0[1], r1[1]}; OUT = *reinterpret_cast<bf16x8*>(&w); } while (0)
  PK4(p0, 0, pa0); PK4(p0, 8, pa1); PK4(p1, 0, pa2); PK4(p1, 8, pa3);
#undef PK4
}
__device__ __forceinline__ void diff_attn_unit_p3(const bf16_t* __restrict__ Zb, int qrow0, int h, int nkeys, bf16_t* __restrict__ Y1b, float lam, const float* __restrict__ subg, char* lds, const CvtCtx& CC, CvtState& CS) {
  const int tid = threadIdx.x, wid = __builtin_amdgcn_readfirstlane(tid >> 6), lane = tid & 63, r32 = lane & 31, hi = lane >> 5;
  const int map = wid >> 2, qw = wid & 3;
  char* V_lds = lds; char* K_lds = lds + 2 * SHM_V;
  float* wsl = (float*)(lds + 2 * SHM_V + 2 * SHM_K) + wid * 64; float* li_l = wsl; float* al_l = wsl + 32;
  float m_reg = -1e30f, l_reg = 0; f32x16 o[4] = {}; bf16x8 qr[4];
  const bf16_t* Qw = Zb + (size_t)(qrow0 + qw * 32 + r32) * LDZ + h * 128 + map * 64 + hi * 8;
#pragma unroll
  for (int d0 = 0; d0 < 4; ++d0) qr[d0] = *reinterpret_cast<const bf16x8*>(Qw + d0 * 16);
  const LAS char* vb0 = (const LAS char*)V_lds + v_rd_base(lane);
  const int cmapB = map * 128;
  const __amdgpu_buffer_rsrc_t rsZ = __builtin_amdgcn_make_buffer_rsrc((void*)Zb, 0, SP * LDZ * 2, 0x00020000);
  int dofV[4], dofK[4];
#pragma unroll
  for (int q = 0; q < 4; ++q) { const int sp = (wid & 3) * 4 + q;
    { const int stl = 2 * sp + (lane >> 5), kk = (stl >> 2) * 8 + ((lane & 31) >> 2), k = (kk & ~0xC) | ((kk & 4) << 1) | ((kk & 8) >> 1), c = (stl & 3) * 32 + (lane & 3) * 8;
      dofV[q] = (k * LDZ + 1024 + h * 128 + c) * 2; }
    { const int r = 4 * sp + (lane >> 4), ch = (lane & 15) ^ (r & 7);
      dofK[q] = (r * LDZ + 512 + h * 128 + ch * 8) * 2; } }
#define DMA_KV(tk, bk, tv, bv) do { if (wid < 4) { const int soV_ = (tv) * (KVBLK * LDZ * 2), soK_ = (tk) * (KVBLK * LDZ * 2); \
    LAS char* lv_ = (LAS char*)lds + (bv) * SHM_V + (wid & 3) * 4096; LAS char* lk_ = (LAS char*)lds + 2 * SHM_V + (bk) * SHM_K + (wid & 3) * 4096; \
    _Pragma("unroll") for (int q = 0; q < 4; ++q) __builtin_amdgcn_raw_ptr_buffer_load_lds(rsZ, (LAS void*)(lv_ + q * 1024), 16, dofV[q], soV_, 0, 0); \
    _Pragma("unroll") for (int q = 0; q < 4; ++q) __builtin_amdgcn_raw_ptr_buffer_load_lds(rsZ, (LAS void*)(lk_ + q * 1024), 16, dofK[q], soK_, 0, 0); } } while (0)
#define TSYNC() do { asm volatile("s_waitcnt vmcnt(0)" ::: "memory"); __syncthreads(); } while (0)
#define RESC(a) do { if (__any((a) < 1.f)) { if (hi == 0) al_l[r32] = (a); asm volatile("s_waitcnt lgkmcnt(0)" ::: "memory"); \
    _Pragma("unroll") for (int d = 0; d < 4; ++d) _Pragma("unroll") for (int r = 0; r < 16; ++r) o[d][r] *= al_l[crow(r, hi)]; } } while (0)
  const int NT = nkeys / KVBLK;
  f32x16 pA0, pA1, pB0, pB1; bf16x8 aA0, aA1, aA2, aA3, aB0, aB1, aB2, aB3; float alpha;
  DMA_KV(0, 0, 0, 0); DMA_KV(1, 1, 0, 0); TSYNC();
  qkt(pA0, pA1, K_lds, qr, r32, hi, cmapB);
  __syncthreads();
#define HALF(T, PC0, PC1, PN0, PN1, AC0, AC1, AC2, AC3, AP0, AP1, AP2, AP3, DOPV) do { \
    const int ph_ = (CS.tick++) & 3; \
    if (wid >= 4) cvt_wave_step(CC, CS, (LAS char*)lds + 67584 + (wid - 4) * 8192, lane, ph_); \
    DMA_KV((T) + 2, (T) & 1, (T), (T) & 1); \
    SBAR(); \
    qkt(PN0, PN1, K_lds + (((T) + 1) & 1) * SHM_K, qr, r32, hi, cmapB); \
    softmax_full(PC0, PC1, m_reg, l_reg, alpha, AC0, AC1, AC2, AC3); \
    if (DOPV) pv_d0(o, vb0 + (((T) + 1) & 1) * SHM_V, AP0, AP1, AP2, AP3); \
    SBAR(); \
    RESC(alpha); \
    if (wid < 4) { asm volatile("s_waitcnt vmcnt(0) lgkmcnt(0)" ::: "memory"); } else { asm volatile("s_waitcnt lgkmcnt(0)" ::: "memory"); } \
    __builtin_amdgcn_s_barrier(); asm volatile("" ::: "memory"); } while (0)
  HALF(0, pA0, pA1, pB0, pB1, aA0, aA1, aA2, aA3, aB0, aB1, aB2, aB3, false);
  for (int t = 1; t + 1 < NT; t += 2) {
    HALF(t, pB0, pB1, pA0, pA1, aB0, aB1, aB2, aB3, aA0, aA1, aA2, aA3, true);
    HALF(t + 1, pA0, pA1, pB0, pB1, aA0, aA1, aA2, aA3, aB0, aB1, aB2, aB3, true);
  }
  HALF(NT - 1, pB0, pB1, pA0, pA1, aB0, aB1, aB2, aB3, aA0, aA1, aA2, aA3, true);
  pv_d0(o, vb0 + SHM_V, aB0, aB1, aB2, aB3);
#undef HALF
#undef DMA_KV
#undef TSYNC
#undef RESC
  if (hi == 0) li_l[r32] = l_reg; asm volatile("s_waitcnt lgkmcnt(0)" ::: "memory");
  float rli[16];
#pragma unroll
  for (int r = 0; r < 16; ++r) rli[r] = __builtin_amdgcn_rcpf(li_l[crow(r, hi)]);
  __syncthreads();
  float* X = (float*)lds + qw * (32 * 128);
  if (map == 1) {
#pragma unroll
    for (int d0 = 0; d0 < 4; ++d0)
#pragma unroll
      for (int r = 0; r < 16; ++r) X[crow(r, hi) * 128 + d0 * 32 + r32] = o[d0][r] * rli[r] * lam;
  }
  __syncthreads();
  if (map == 0) {
    float ss[16];
#pragma unroll
    for (int r = 0; r < 16; ++r) ss[r] = 0.f;
#pragma unroll
    for (int d0 = 0; d0 < 4; ++d0)
#pragma unroll
      for (int r = 0; r < 16; ++r) { const float v = o[d0][r] * rli[r] - X[crow(r, hi) * 128 + d0 * 32 + r32]; o[d0][r] = v; ss[r] += v * v; }
#pragma unroll
    for (int r = 0; r < 16; ++r) {
      ss[r] = half32_sum(ss[r]);
      ss[r] = 0.8f * __builtin_amdgcn_rsqf(ss[r] * (1.0f / 128.0f) + EPSN); }
    int r32e = r32; asm volatile("" : "+v"(r32e));
    float gv[4];
#pragma unroll
    for (int d0 = 0; d0 < 4; ++d0) gv[d0] = subg[d0 * 32 + r32e];
    bf16_t* Ow = Y1b + (size_t)(qrow0 + qw * 32) * DM + h * 128 + r32e;
#pragma unroll
    for (int r = 0; r < 16; ++r) { const int orow = crow(r, hi);
#pragma unroll
      for (int d0 = 0; d0 < 4; ++d0) { const unsigned w = cvt_pk_bf16(o[d0][r] * ss[r] * gv[d0], 0.f); Ow[(size_t)orow * DM + d0 * 32] = (bf16_t)(w & 0xffffu); } }
  }
  __syncthreads();
}
#undef KSWZ
#undef SBAR
}
struct Args { const float* in[33]; float* out; unsigned char* ws; int ph_lo, ph_hi; };
struct Frame {
    LAS unsigned char* lds; unsigned char* ldsg;
    int tid, lane, wave, G, vcu, gw, ngw;
    unsigned char* ws; float* out;
    const struct Args* a;
};
__device__ __forceinline__ void tok_decode(int r, int& b, bool& ctx, int& p) { b = r / SP; const int q = r - b * SP; ctx = q < CTXL; p = ctx ? q : q - CTXL; }

__device__ __forceinline__ void row_load(const float* row, int lane, f32x4 (&v)[4]) {
    const f32x4* p = (const f32x4*)row + lane;
#pragma unroll
    for (int j = 0; j < 4; ++j) v[j] = p[64 * j];
}
__device__ __forceinline__ void row_load_bf16(const bf16_t* row, int lane, f32x4 (&v)[4]) {
    const u32x2* p = (const u32x2*)row + lane;
#pragma unroll
    for (int j = 0; j < 4; ++j) { const u32x2 w = p[64 * j]; v[j] = (f32x4){bflo(w.x), bfhi(w.x), bflo(w.y), bfhi(w.y)}; }
}
__device__ __forceinline__ float row_sumsq(const f32x4 (&v)[4]) { float s = 0.f;
#pragma unroll
    for (int j = 0; j < 4; ++j) s += (v[j].x * v[j].x + v[j].y * v[j].y) + (v[j].z * v[j].z + v[j].w * v[j].w);
    return wave_sum(s); }
__device__ __forceinline__ void row_norm_mod(f32x4 (&v)[4], float rstd, const float* g, const float* shift, const float* scale, int lane) {
#pragma unroll
    for (int j = 0; j < 4; ++j) { const int c = 4 * lane + 256 * j; const f32x4 gg = *(const f32x4*)(g + c), sh = *(const f32x4*)(shift + c), sc = *(const f32x4*)(scale + c);
        v[j] = v[j] * rstd * gg * (sc + 1.0f) + sh; }
}
__device__ __forceinline__ void row_store_fp8(unsigned char* row, int lane, const f32x4 (&v)[4]) {
    unsigned* p = (unsigned*)row + lane;
#pragma unroll
    for (int j = 0; j < 4; ++j) p[64 * j] = pk4_fp8(v[j].x, v[j].y, v[j].z, v[j].w);
}
__device__ __forceinline__ void row_store_bf16(bf16_t* row, int lane, const f32x4 (&v)[4]) {
    u32x2* p = (u32x2*)row + lane;
#pragma unroll
    for (int j = 0; j < 4; ++j) { u32x2 w; w.x = cvt_pk_bf16(v[j].x, v[j].y); w.y = cvt_pk_bf16(v[j].z, v[j].w); p[64 * j] = w; }
}

__device__ __forceinline__ void phase_norm1_l0(Frame& F) {
    const float* x = F.a->in[0]; const float* cx = F.a->in[2]; const float* g = F.a->in[6]; const float* MOD = (const float*)(F.ws + WS_MOD); bf16_t* A1 = (bf16_t*)(F.ws + WS_A1);
    const int r0 = (int)(((long)F.gw * NTOK) / F.ngw), r1 = (int)(((long)(F.gw + 1) * NTOK) / F.ngw);
    for (int r = r0; r < r1; ++r) { int b, p; bool ctx; tok_decode(r, b, ctx, p);
        const float* hrow = ctx ? cx + ((size_t)b * CTXL + p) * DM : x + ((size_t)b * SEQ + p) * DM; const float* md = MOD + (ctx ? 4 : b) * 6144;
        f32x4 v[4]; row_load(hrow, F.lane, v); const float rstd = __builtin_amdgcn_rsqf(row_sumsq(v) * (1.0f / DM) + EPSN);
        row_norm_mod(v, rstd, g, md, md + 1024, F.lane); row_store_bf16(A1 + (size_t)r * DM, F.lane, v); }
}

__device__ __forceinline__ void phase_norm2_router(Frame& F, int layer, bool with_ctx) {
    const float* g = F.a->in[7] + layer * DM; const float* rw = F.a->in[8] + (size_t)layer * DM * NEXP; const float* MOD = (const float*)(F.ws + WS_MOD) + layer * 5 * 6144;
    bf16_t* A1 = (bf16_t*)(F.ws + WS_A1); float* AFF = (float*)(F.ws + WS_AFF); float* AFFC = (float*)(F.ws + WS_AFFC);
    const bf16_t* HB = (const bf16_t*)(F.ws + WS_HB);
    LAS float* RT = (LAS float*)F.lds;
    for (int idx = F.tid; idx < DM * 4; idx += NTHR) { const int d = idx >> 2, q = idx & 3; const int ln = (d & 255) >> 2, i = d & 3, j = d >> 8;
        *(LAS f32x4*)(RT + ((j * 4 + i) * 64 + ln) * 20 + q * 4) = *(const f32x4*)(rw + d * 16 + q * 4); }
    __syncthreads();
    int myexp; { float ids[16];
#pragma unroll
        for (int e = 0; e < 16; ++e) ids[e] = (F.lane == 0) ? (float)e : 0.f;
        myexp = (int)(reduce_scatter16(ids, F.lane) + 0.5f); }
    const int r0 = (int)(((long)F.gw * NTOK) / F.ngw), r1 = (int)(((long)(F.gw + 1) * NTOK) / F.ngw);
    for (int r = r0; r < r1; ++r) { int b, p; bool ctx; tok_decode(r, b, ctx, p);
        if (ctx && !with_ctx) continue;
        const float* md = MOD + (ctx ? 4 : b) * 6144;
        f32x4 v[4]; row_load_bf16(HB + (size_t)r * DM, F.lane, v); const float rstd = __builtin_amdgcn_rsqf(row_sumsq(v) * (1.0f / DM) + EPSN);
        row_norm_mod(v, rstd, g, md + 3072, md + 4096, F.lane); row_store_fp8((unsigned char*)A1 + (size_t)r * DM, F.lane, v);
        float lg[16];
#pragma unroll
        for (int e = 0; e < 16; ++e) lg[e] = 0.f;
        int rtoff = F.lane * 20; asm volatile("" : "+v"(rtoff));
#pragma unroll
        for (int j = 0; j < 4; ++j)
#pragma unroll
            for (int i = 0; i < 4; ++i) { const float xv = v[j][i]; const LAS f32x4* wp = (const LAS f32x4*)(RT + (j * 4 + i) * 64 * 20 + rtoff);
#pragma unroll
                for (int q = 0; q < 4; ++q) { const f32x4 w = wp[q]; lg[4 * q + 0] += xv * w.x; lg[4 * q + 1] += xv * w.y; lg[4 * q + 2] += xv * w.z; lg[4 * q + 3] += xv * w.w; } }
        const float tot = reduce_scatter16(lg, F.lane);
        const float mx = wave_max(tot); const float ex = __expf(tot - mx); const float sum = wave_sum(ex) * 0.25f;
        const float mine = ex / sum;
        if ((F.lane & 3) == 0) { if (ctx) AFFC[((size_t)b * NEXP + myexp) * CTXL + p] = mine; else AFF[((size_t)b * NEXP + myexp) * SEQ + p] = mine; }
    }
    __syncthreads();
}

__device__ __forceinline__ void select_unit(Frame& F, const float* aff, int n, int cap, int* slot_of, int* tok, int tok_base) {
    volatile LAS int* red = (volatile LAS int*)F.lds;
    const int tid = F.tid, lane = F.lane, wid = F.wave;
    unsigned v[16];
    const int i0 = tid * 16;
#pragma unroll
    for (int q = 0; q < 4; ++q) { u32x4 t = {0u, 0u, 0u, 0u}; if (i0 + 4 * q < n) t = *(const u32x4*)((const unsigned*)aff + i0 + 4 * q); v[4 * q] = t.x; v[4 * q + 1] = t.y; v[4 * q + 2] = t.z; v[4 * q + 3] = t.w; }
    unsigned T = 0u; int buf = 0;
    for (int bit = 30; bit >= 0; --bit) { const unsigned cand = T | (1u << bit); int c = 0;
#pragma unroll
        for (int i = 0; i < 16; ++i) c += (v[i] >= cand) ? 1 : 0;
        c = wave_sum_i(c); if (lane == 0) red[buf * 8 + wid] = c;
        __syncthreads();
        int tot = 0;
#pragma unroll
        for (int w = 0; w < 8; ++w) tot += red[buf * 8 + w];
        if (tot >= cap) T = cand; buf ^= 1; }
    int cg = 0, ce = 0;
#pragma unroll
    for (int i = 0; i < 16; ++i) { cg += (v[i] > T) ? 1 : 0; ce += (v[i] == T) ? 1 : 0; }
    int sg = cg, se = ce;
#pragma unroll
    for (int o = 1; o < 64; o <<= 1) { const int tg = __shfl_up(sg, o), te = __shfl_up(se, o); if (lane >= o) { sg += tg; se += te; } }
    __syncthreads();
    if (lane == 63) { red[32 + wid] = sg; red[48 + wid] = se; }
    __syncthreads();
    int offg = 0, offe = 0, totg = 0;
#pragma unroll
    for (int w = 0; w < 8; ++w) { const int a = red[32 + w], e2 = red[48 + w]; if (w < wid) { offg += a; offe += e2; } totg += a; }
    const int exg = offg + sg - cg, exe = offe + se - ce;
    const int need_eq = cap - totg;
    int take_e = need_eq - exe; take_e = take_e < 0 ? 0 : (take_e > ce ? ce : take_e);
    const int selcnt = cg + take_e;
    int ss = selcnt;
#pragma unroll
    for (int o = 1; o < 64; o <<= 1) { const int t2 = __shfl_up(ss, o); if (lane >= o) ss += t2; }
    __syncthreads();
    if (lane == 63) red[32 + wid] = ss;
    __syncthreads();
    int offs = 0;
#pragma unroll
    for (int w = 0; w < 8; ++w) { const int a = red[32 + w]; if (w < wid) offs += a; }
    int slot = offs + ss - selcnt; int eq_left = take_e;
    (void)exg;
    int so[16];
#pragma unroll
    for (int i = 0; i < 16; ++i) { bool sel = v[i] > T; if (v[i] == T && eq_left > 0) { sel = true; --eq_left; }
        so[i] = sel ? slot : -1; if (sel) { if (i0 + i < n) tok[slot] = tok_base + i0 + i; ++slot; } }
    if (i0 < n) {
#pragma unroll
        for (int q = 0; q < 4; ++q) *(u32x4*)((unsigned*)slot_of + i0 + 4 * q) = (u32x4){(unsigned)so[4 * q], (unsigned)so[4 * q + 1], (unsigned)so[4 * q + 2], (unsigned)so[4 * q + 3]}; }
    __syncthreads();
}
__device__ __forceinline__ void phase_select(Frame& F, bool with_ctx) {
    const float* AFF = (const float*)(F.ws + WS_AFF); const float* AFFC = (const float*)(F.ws + WS_AFFC);
    int* SLOT = (int*)(F.ws + WS_SLOT); int* SLOTC = (int*)(F.ws + WS_SLOTC); int* TOK = (int*)(F.ws + WS_TOK);
    const int nu = with_ctx ? 128 : 64;
    for (int u = blockIdx.x; u < nu; u += F.G) {
        if (u < 64) { const int b = u >> 4, e = u & 15;
            select_unit(F, AFF + ((size_t)b * NEXP + e) * SEQ, SEQ, CAPL, SLOT + ((size_t)b * NEXP + e) * SEQ, TOK + e * XROWS + b * CAPL, b * SP + CTXL);
        } else { const int b = (u - 64) >> 4, e = u & 15;
            select_unit(F, AFFC + ((size_t)b * NEXP + e) * CTXL, CTXL, CAPC, SLOTC + ((size_t)b * NEXP + e) * CTXL, TOK + e * XROWS + 4096 + b * CAPC, b * SP); }
    }
}
__device__ __forceinline__ void phase_gather(Frame& F, bool with_ctx) {
    const bf16_t* A1 = (const bf16_t*)(F.ws + WS_A1); unsigned char* XS = (unsigned char*)(F.ws + WS_XS); const int* TOK = (const int*)(F.ws + WS_TOK);
    const int rows_e = with_ctx ? 4224 : 4096, total = NEXP * rows_e;
    for (int it = F.gw; it < total; it += F.ngw) { const int e = it / rows_e, row = it - e * rows_e; const int tk = TOK[e * XROWS + row];
        const u32x4* src = (const u32x4*)(A1 + (size_t)tk * DM) + 2 * F.lane; const u32x4 a = src[0], c = src[1];
        u32x4 o; o.x = pk4_fp8(bflo(a.x), bfhi(a.x), bflo(a.y), bfhi(a.y)); o.y = pk4_fp8(bflo(a.z), bfhi(a.z), bflo(a.w), bfhi(a.w));
        o.z = pk4_fp8(bflo(c.x), bfhi(c.x), bflo(c.y), bfhi(c.y)); o.w = pk4_fp8(bflo(c.z), bfhi(c.z), bflo(c.w), bfhi(c.w));
        *((u32x4*)(XS + ((size_t)e * XROWS + row) * DM) + F.lane) = o; }
}
__device__ __forceinline__ void phase_combine(Frame& F, int layer, bool with_ctx, int mode, bool dry = false) {
    const float* MOD = (const float*)(F.ws + WS_MOD) + layer * 5 * 6144;
    const float* AFF = (const float*)(F.ws + WS_AFF); const float* AFFC = (const float*)(F.ws + WS_AFFC);
    const int* SLOT = (const int*)(F.ws + WS_SLOT); const int* SLOTC = (const int*)(F.ws + WS_SLOTC);
    const unsigned char* YS = (const unsigned char*)(F.ws + WS_XS); bf16_t* A1 = (bf16_t*)(F.ws + WS_A1);
    float* hl = F.out; bf16_t* HB = (bf16_t*)(F.ws + WS_HB);
    const float* gnext = (mode == 0) ? F.a->in[6] + (layer + 1) * DM : F.a->in[32]; const float* MODN = (const float*)(F.ws + WS_MOD) + (layer + 1) * 5 * 6144;
    int r0 = (int)(((long)F.gw * NTOK) / F.ngw); const int r1 = (int)(((long)(F.gw + 1) * NTOK) / F.ngw);
    const int le = F.lane & 15;
#define CMB_REQ(r, SL, AF, HV) do { int b_, p_; bool c_; tok_decode((r), b_, c_, p_); \
        const size_t o_ = c_ ? ((size_t)b_ * NEXP + le) * CTXL + p_ : ((size_t)b_ * NEXP + le) * SEQ + p_; \
        SL = c_ ? SLOTC[o_] : SLOT[o_]; AF = c_ ? AFFC[o_] : AFF[o_]; \
        row_load_bf16(HB + (size_t)(r) * DM, F.lane, HV); } while (0)
    if (!with_ctx) { int b, p; bool ctx; while (r0 < r1) { tok_decode(r0, b, ctx, p); if (!ctx) break; ++r0; } }
    if (r0 >= r1) return;
    int sl_n; float af_n; f32x4 hv_n[4];
    CMB_REQ(r0, sl_n, af_n, hv_n);
    for (int r = r0; r < r1; ++r) { int b, p; bool ctx; tok_decode(r, b, ctx, p);
        if (ctx && !with_ctx) continue;
        const int sl = sl_n; const float af = af_n; f32x4 v[4];
#pragma unroll
        for (int j = 0; j < 4; ++j) v[j] = hv_n[j];
        { int rn = r + 1; if (!with_ctx) { int b2, p2; bool c2; while (rn < r1) { tok_decode(rn, b2, c2, p2); if (!c2) break; ++rn; } }
          if (rn < r1) CMB_REQ(rn, sl_n, af_n, hv_n); }
        const float* md = MOD + (ctx ? 4 : b) * 6144;
        f32x4 acc[4];
#pragma unroll
        for (int j = 0; j < 4; ++j) acc[j] = (f32x4){0.f, 0.f, 0.f, 0.f};
        unsigned mask = (unsigned)(__ballot(sl >= 0) & 0xffffull);
        const size_t rowbase = ctx ? (size_t)(4096 + b * CAPC) : (size_t)(b * CAPL);
        while (mask) {
            int e[4]; float gq[4]; const unsigned* yp[4];
#pragma unroll
            for (int q = 0; q < 4; ++q) { const bool ok = mask != 0u; const int eb = ok ? (int)__builtin_ctz(mask) : 0; mask = ok ? (mask & (mask - 1u)) : 0u;
                e[q] = ok ? eb : e[0]; const int s = __shfl(sl, e[q]); gq[q] = ok ? __shfl(af, e[q]) * (1.0f / pg8::YS_SCALE) : 0.f;
                yp[q] = (const unsigned*)(YS + ((size_t)e[q] * XROWS + rowbase + (s < 0 ? 0 : s)) * DM) + F.lane; }
            unsigned w[4][4];
#pragma unroll
            for (int q = 0; q < 4; ++q)
#pragma unroll
                for (int j = 0; j < 4; ++j) w[q][j] = yp[q][64 * j];
#pragma unroll
            for (int q = 0; q < 4; ++q)
#pragma unroll
                for (int j = 0; j < 4; ++j) { const auto lo = __builtin_amdgcn_cvt_pk_f32_fp8((int)w[q][j], false), hi2 = __builtin_amdgcn_cvt_pk_f32_fp8((int)w[q][j], true);
                    acc[j].x += gq[q] * lo[0]; acc[j].y += gq[q] * lo[1]; acc[j].z += gq[q] * hi2[0]; acc[j].w += gq[q] * hi2[1]; }
        }
#pragma unroll
        for (int j = 0; j < 4; ++j) { const f32x4 gt = *(const f32x4*)(md + 5120 + 4 * F.lane + 256 * j); v[j] = v[j] + gt * acc[j]; }
        const float rstd = __builtin_amdgcn_rsqf(row_sumsq(v) * (1.0f / DM) + EPSN);
        bf16_t* A1w = A1; (void)dry;
        if (mode == 0) {
            row_store_bf16(HB + (size_t)r * DM, F.lane, v);
            const float* mdn = MODN + (ctx ? 4 : b) * 6144;
            row_norm_mod(v, rstd, gnext, mdn, mdn + 1024, F.lane); row_store_fp8((unsigned char*)A1w + (size_t)r * DM, F.lane, v);
        } else {
#pragma unroll
            for (int j = 0; j < 4; ++j) { const f32x4 gg = *(const f32x4*)(gnext + 4 * F.lane + 256 * j); ((f32x4*)(hl + ((size_t)b * SEQ + p) * DM) + F.lane)[64 * j] = v[j] * rstd * gg; }
        }
    }
#undef CMB_REQ
}
__device__ __forceinline__ void phase_pool(Frame& F) {
    const bf16_t* Z = (const bf16_t*)(F.ws + WS_Z); bf16_t* Y1 = (bf16_t*)(F.ws + WS_Y1);
    const int skip = (F.G == 256) ? 32 : 0; if (F.vcu < skip) return;
    const int pw = (F.vcu - skip) * NWAVES + F.wave, npw = (F.G - skip) * NWAVES;
    const int r0 = (int)(((long)pw * NTOK) / npw), r1 = (int)(((long)(pw + 1) * NTOK) / npw);
    const int half = 1 << (F.lane >> 4);
    for (int r = r0; r < r1; ++r) { int b, p; bool ctx; tok_decode(r, b, ctx, p); const int n = ctx ? CTXL : SEQ; const int rbase = r - p;
        int lo = p - half; lo = lo < 0 ? 0 : lo; int hi = p + half - 1; hi = hi > n - 1 ? n - 1 : hi;
        float s[8];
#pragma unroll
        for (int i = 0; i < 8; ++i) s[i] = 0.f;
        float own[8];
#pragma unroll
        for (int i = 0; i < 8; ++i) own[i] = 0.f;
        u32x4 w16[16];
#pragma unroll
        for (int j = 0; j < 16; ++j) { int q = p + j - 8; q = q < 0 ? 0 : (q > n - 1 ? n - 1 : q); w16[j] = *((const u32x4*)(Z + (size_t)(rbase + q) * 2048 + 1536) + F.lane); }
#pragma unroll
        for (int j = 0; j < 16; ++j) { const int q = p + j - 8; const u32x4 w = w16[j];
            float f[8] = {bflo(w.x), bfhi(w.x), bflo(w.y), bfhi(w.y), bflo(w.z), bfhi(w.z), bflo(w.w), bfhi(w.w)};
            const bool in = (q >= lo) && (q <= hi);
#pragma unroll
            for (int i = 0; i < 8; ++i) { s[i] += in ? f[i] : 0.f; if (j == 8) own[i] = f[i]; } }
        const float inv = 1.0f / (float)(hi - lo + 1);
        f32x4 o0 = {s[0] * inv - own[0], s[1] * inv - own[1], s[2] * inv - own[2], s[3] * inv - own[3]}, o1 = {s[4] * inv - own[4], s[5] * inv - own[5], s[6] * inv - own[6], s[7] * inv - own[7]};
        *((u32x4*)(Y1 + (size_t)r * DM + 512) + F.lane) = pg8::pack8(o0, o1); }
}
__device__ __forceinline__ void phase_attn(Frame& F) {
    const bf16_t* Z = (const bf16_t*)(F.ws + WS_Z); bf16_t* Y1 = (bf16_t*)(F.ws + WS_Y1); const float lam = *(const float*)(F.ws + WS_LAM); const float* subg = F.a->in[18];
    const dattn::CvtCtx CC{F.a->in[9], F.a->in[10], F.a->in[11], (unsigned char*)(F.ws + WS_GU), (unsigned char*)(F.ws + WS_DN), (int)blockIdx.x * 4 + (F.wave & 3), F.G * 4, F.wave >= 4 ? 2 * 16 * 3 * 1024 : 0};
    dattn::CvtState CS{0, -1, 0, (int)(blockIdx.x >> 3)};
    for (int L = F.vcu; L < 1024 + 32; L += F.G) {
        if (L < 1024) { const int bh = L >> 6, qb = L & 63; const int b = bh >> 2, h = bh & 3;
            dattn::diff_attn_unit_p3(Z + (size_t)b * SP * 2048, CTXL + qb * 128, h, SP, Y1 + (size_t)b * SP * DM, lam, subg, (char*)F.ldsg, CC, CS);
        } else { const int l = L - 1024; const int bh = l >> 1, qb = l & 1; const int b = bh >> 2, h = bh & 3;
            dattn::diff_attn_unit_p3(Z + (size_t)b * SP * 2048, qb * 128, h, CTXL, Y1 + (size_t)b * SP * DM, lam, subg, (char*)F.ldsg, CC, CS); }
    }
    if (F.wave >= 4) dattn::cvt_drain(CC, CS, (LAS char*)F.ldsg + 67584 + (F.wave - 4) * 8192, F.lane);
    phase_pool(F);
}
__device__ __forceinline__ void p0_mod(Frame& F, int l0, int l1, int b0, int nb) {
    if ((int)blockIdx.x < b0 || (int)blockIdx.x >= b0 + nb) return;
    LAS float* cond = (LAS float*)F.lds;
    LAS float* red = cond + 5 * 1024;
    const float* c = F.a->in[1]; const float* cc = F.a->in[3]; const float* aw = F.a->in[4]; const float* ab = F.a->in[5]; float* MOD = (float*)(F.ws + WS_MOD);
    for (int i = F.tid; i < 5 * 1024; i += NTHR) { const float x = (i < 4096) ? c[i] : cc[i - 4096]; cond[i] = siluf_(x); }
    __syncthreads();
    for (int it = l0 * 96 + (int)blockIdx.x - b0; it < l1 * 96; it += nb) { const int layer = it / 96, cb = it - layer * 96; const int col = cb * 64 + F.lane;
        const float* W = aw + (size_t)layer * DM * 6144 + col; float acc[5] = {0.f, 0.f, 0.f, 0.f, 0.f};
        const int k0 = F.wave * 128;
#pragma unroll 8
        for (int k = k0; k < k0 + 128; ++k) { const float w = W[(size_t)k * 6144];
#pragma unroll
            for (int r = 0; r < 5; ++r) acc[r] += cond[r * 1024 + k] * w; }
#pragma unroll
        for (int r = 0; r < 5; ++r) red[(F.wave * 5 + r) * 64 + F.lane] = acc[r];
        __syncthreads();
        if (F.tid < 320) { const int r = F.tid >> 6, ln = F.tid & 63; float s = 0.f;
#pragma unroll
            for (int w = 0; w < 8; ++w) s += red[(w * 5 + r) * 64 + ln];
            MOD[((size_t)layer * 5 + r) * 6144 + cb * 64 + ln] = s + ab[layer * 6144 + cb * 64 + ln]; }
        __syncthreads();
    }
}
__device__ __forceinline__ void p0_transpose_item(const float* Wb, int ldw, bf16_t* Db, int ldd, LAS float* scr, int lane) {
#pragma unroll 8
    for (int i = 0; i < 32; ++i) { const int kk = 2 * i + (lane >> 5); scr[kk * 33 + (lane & 31)] = Wb[(size_t)kk * ldw + (lane & 31)]; }
    LDS_WAIT(); asm volatile("" ::: "memory");
    const int c = lane & 7;
#pragma unroll
    for (int j = 0; j < 4; ++j) { const int n = (lane >> 3) + 8 * j; const LAS float* s = scr + (8 * c) * 33 + n;
        u32x4 o; o.x = cvt_pk_bf16(s[0 * 33], s[1 * 33]); o.y = cvt_pk_bf16(s[2 * 33], s[3 * 33]); o.z = cvt_pk_bf16(s[4 * 33], s[5 * 33]); o.w = cvt_pk_bf16(s[6 * 33], s[7 * 33]);
        *(u32x4*)(Db + (size_t)n * ldd + 8 * c) = o; }
    LDS_WAIT(); asm volatile("" ::: "memory");
}
__device__ __forceinline__ void p0_transpose_item_f8(const float* Wb, int ldw, unsigned char* Db, int ldd, float sc, LAS float* scr, int lane) {
#pragma unroll 8
    for (int i = 0; i < 32; ++i) { const int kk = 2 * i + (lane >> 5); scr[kk * 33 + (lane & 31)] = Wb[(size_t)kk * ldw + (lane & 31)] * sc; }
    LDS_WAIT(); asm volatile("" ::: "memory");
    const int c = lane & 3;
#pragma unroll
    for (int j = 0; j < 2; ++j) { const int n = (lane >> 2) + 16 * j; const LAS float* s = scr + (16 * c) * 33 + n;
        u32x4 o; o.x = pk4_fp8(s[0 * 33], s[1 * 33], s[2 * 33], s[3 * 33]); o.y = pk4_fp8(s[4 * 33], s[5 * 33], s[6 * 33], s[7 * 33]);
        o.z = pk4_fp8(s[8 * 33], s[9 * 33], s[10 * 33], s[11 * 33]); o.w = pk4_fp8(s[12 * 33], s[13 * 33], s[14 * 33], s[15 * 33]);
        *(u32x4*)(Db + (size_t)n * ldd + 16 * c) = o; }
    LDS_WAIT(); asm volatile("" ::: "memory");
}
__device__ __forceinline__ void p0_weights(Frame& F, int lo, int hi, int w0, int nw) {
    LAS float* scr = (LAS float*)(F.lds + 32768 + F.wave * 8704);
    constexpr int I_IN = 16 * 64, I_OUT = 8 * 32, I_S = 16 * 32, I_E = 16 * 64;
    constexpr int NITEMS = I_IN + I_OUT + 3 * I_S;
    bf16_t* WIN = (bf16_t*)(F.ws + WS_WIN); bf16_t* WOUT = (bf16_t*)(F.ws + WS_WOUT); unsigned char* GU = (unsigned char*)(F.ws + WS_GU); unsigned char* DN = (unsigned char*)(F.ws + WS_DN);
    if (F.gw < w0 || F.gw >= w0 + nw) return;
    if (hi > NITEMS) hi = NITEMS;
    for (int it = lo + F.gw - w0; it < hi; it += nw) {
        int r = it;
        if (r < I_IN) { const int kb = r / 64, nb = r % 64; p0_transpose_item(F.a->in[12] + (size_t)(kb * 64) * 2048 + nb * 32, 2048, WIN + (size_t)(nb * 32) * 1024 + kb * 64, 1024, scr, F.lane); continue; } r -= I_IN;
        if (r < I_OUT) { const int kb = r / 32, nb = r % 32; p0_transpose_item(F.a->in[13] + (size_t)(kb * 64) * 1024 + nb * 32, 1024, WOUT + (size_t)(nb * 32) * 1024 + kb * 64, 1024, scr, F.lane); continue; } r -= I_OUT;
        if (r < 3 * I_S) { const int m = r / I_S, q = r % I_S, kb = q / 32, nb = q % 32; const float* W = m == 0 ? F.a->in[21] : (m == 1 ? F.a->in[30] : F.a->in[31]);
            bf16_t* Dst = (bf16_t*)(F.ws + (m == 0 ? WS_SWIN : (m == 1 ? WS_SWGLU : WS_SWOUT)));
            if (m == 0) p0_transpose_item_f8(W + (size_t)(kb * 64) * 1024 + nb * 32, 1024, (unsigned char*)Dst + (size_t)(nb * 32) * 1024 + kb * 64, 1024, 32.f, scr, F.lane);
            else p0_transpose_item(W + (size_t)(kb * 64) * 1024 + nb * 32, 1024, Dst + (size_t)(nb * 32) * 1024 + kb * 64, 1024, scr, F.lane);
            continue; }
        (void)r;
    }
}
__device__ __forceinline__ void p0_poolfold(Frame& F, int w0, int nw) {
    const float* pw = F.a->in[19]; const float* ps = F.a->in[20]; const float* wo = F.a->in[13]; bf16_t* WOUT = (bf16_t*)(F.ws + WS_WOUT);
    if (F.gw < w0 || F.gw >= w0 + nw) return;
    for (int it = F.gw - w0; it < 4 * 16 * 16; it += nw) { const int g = it >> 8, cb = (it >> 4) & 15, nb = it & 15; const int n = nb * 64 + F.lane;
        float acc[8] = {0.f, 0.f, 0.f, 0.f, 0.f, 0.f, 0.f, 0.f};
        for (int e = 0; e < 128; ++e) { const float w = wo[(size_t)(512 + g * 128 + e) * 1024 + n] * ps[g * 128 + e];
#pragma unroll
            for (int i = 0; i < 8; ++i) acc[i] += pw[((size_t)g * 128 + cb * 8 + i) * 128 + e] * w; }
        u32x4 o; o.x = cvt_pk_bf16(acc[0], acc[1]); o.y = cvt_pk_bf16(acc[2], acc[3]); o.z = cvt_pk_bf16(acc[4], acc[5]); o.w = cvt_pk_bf16(acc[6], acc[7]);
        *(u32x4*)(WOUT + (size_t)n * 1024 + 512 + g * 128 + cb * 8) = o; }
}
__device__ __forceinline__ float expf_(float x) { return __builtin_amdgcn_exp2f(x * 1.4426950408889634f); }
__device__ __forceinline__ float sin2pi_(float rev) { return __builtin_amdgcn_sinf(__builtin_amdgcn_fractf(rev)); }
__device__ __forceinline__ float cos2pi_(float rev) { return __builtin_amdgcn_cosf(__builtin_amdgcn_fractf(rev)); }
__device__ __forceinline__ void p0_tables(Frame& F, int b0, int nb) {
    if ((int)blockIdx.x < b0 || (int)blockIdx.x >= b0 + nb) return;
    const int gt = ((int)blockIdx.x - b0) * NTHR + F.tid, NT_ = nb * NTHR;
    constexpr float INV2PI = 0.15915494309189535f;
    float* ropec = (float*)(F.ws + WS_ROPE); float* ropes = ropec + 128 * 16;
    for (int i = gt; i < 128 * 16; i += NT_) { const int pos = i >> 4, f = i & 15; const float inv = __builtin_amdgcn_exp2f(-(float)f * (13.287712379549449f / 16.0f)); const float rev = (float)pos * inv * INV2PI;
        ropec[i] = cos2pi_(rev); ropes[i] = sin2pi_(rev); }
    if (gt == 0) { float s1 = 0.f, s2 = 0.f; for (int i = 0; i < 64; ++i) { s1 += F.a->in[14][i] * F.a->in[15][i]; s2 += F.a->in[16][i] * F.a->in[17][i]; }
        *(float*)(F.ws + WS_LAM) = expf_(s1) - expf_(s2) + (0.8f - 0.6f); }
    float2* APOW = (float2*)(F.ws + WS_APOW); float2* BBAR = (float2*)(F.ws + WS_BBAR);
    for (int i = gt; i < 2 * SG * SN; i += NT_) {
        const int dg = i >> 6; const float lre = F.a->in[22][i], lim = F.a->in[23][i], dt = expf_(F.a->in[24][dg]);
        const float mag = expf_(lre * dt), rev = lim * dt * INV2PI, ar = mag * cos2pi_(rev), ai = mag * sin2pi_(rev);
        const float rden = 1.0f / (lre * lre + lim * lim); const float qr = ((ar - 1.0f) * lre + ai * lim) * rden, qi = (ai * lre - (ar - 1.0f) * lim) * rden;
#pragma unroll 1
        for (int c = 0; c < SC; ++c) { const float br = F.a->in[25][(size_t)i * SC + c], bi = F.a->in[26][(size_t)i * SC + c]; BBAR[(size_t)i * SC + c] = make_float2(qr * br - qi * bi, qr * bi + qi * br); }
        float pr = 1.0f, pi = 0.0f;
#pragma unroll 1
        for (int t = 0; t <= SL; ++t) { APOW[(size_t)i * (SL + 1) + t] = make_float2(pr, pi); const float nr = pr * ar - pi * ai, ni = pr * ai + pi * ar; pr = nr; pi = ni; }
    }
}
__device__ __forceinline__ void p1_ktab(Frame& F) {
    const int gt = blockIdx.x * NTHR + F.tid, NT_ = F.G * NTHR;
    const float2* APOW = (const float2*)(F.ws + WS_APOW); const float2* BBAR = (const float2*)(F.ws + WS_BBAR); float* KTAB = (float*)(F.ws + WS_KTAB);
    for (int i = gt; i < 2 * SG * 4 * 256; i += NT_) { const int cp = i & 15, c = (i >> 4) & 15, tau0 = ((i >> 8) & 3) * 8, dg = i >> 10;
        const float* cre = F.a->in[27] + ((size_t)dg * SC + c) * SN; const float* cim = F.a->in[28] + ((size_t)dg * SC + c) * SN; float s[8];
#pragma unroll
        for (int t = 0; t < 8; ++t) s[t] = 0.f;
#pragma unroll 8
        for (int n = 0; n < SN; ++n) { const float2* ap = APOW + ((size_t)dg * SN + n) * (SL + 1); const float2 a = ap[1], p0 = ap[tau0], bb = BBAR[((size_t)dg * SN + n) * SC + cp];
            const float cr = cre[n], ci = cim[n]; const float qr = cr * bb.x - ci * bb.y, qi = cr * bb.y + ci * bb.x; float px = p0.x, py = p0.y;
#pragma unroll
            for (int t = 0; t < 8; ++t) { s[t] += qr * px - qi * py; const float nx = px * a.x - py * a.y, ny = px * a.y + py * a.x; px = nx; py = ny; } }
#pragma unroll
        for (int t = 0; t < 8; ++t) KTAB[((((size_t)dg * SL + tau0 + t) * 16 + c) * 16) + cp] = s[t]; }
}
__device__ __forceinline__ void p2_operators(Frame& F) {
    const int skip = (F.G == 256) ? 32 : 0; if ((int)blockIdx.x < skip) return;
    const int gt = ((int)blockIdx.x - skip) * NTHR + F.tid, NT_ = (F.G - skip) * NTHR;
    const float2* APOW = (const float2*)(F.ws + WS_APOW); const float2* BBAR = (const float2*)(F.ws + WS_BBAR); const float* KTAB = (const float*)(F.ws + WS_KTAB);
    bf16_t* TQ = (bf16_t*)(F.ws + WS_TQ); bf16_t* POP = (bf16_t*)(F.ws + WS_POP); const float* dsk = F.a->in[29];
#pragma unroll 2
    for (int i = gt; i < SG * 512 * 64; i += NT_) { const int cb = i & 63, row = (i >> 6) & 511, g = i >> 15; const int t = row >> 4, c = row & 15; const int j = cb >> 1, cp0 = (cb & 1) * 8;
        const int ta = t - j, tb = j - t;
        const float* ka = KTAB + ((((size_t)0 * SG + g) * SL + (ta < 0 ? 0 : ta)) * 16 + c) * 16 + cp0;
        const float* kb = KTAB + ((((size_t)1 * SG + g) * SL + (tb < 0 ? 0 : tb)) * 16 + c) * 16 + cp0;
        const f32x4 a0 = *(const f32x4*)ka, a1 = *(const f32x4*)(ka + 4), b0 = *(const f32x4*)kb, b1 = *(const f32x4*)(kb + 4); const float d = dsk[g * 16 + c];
        const float fa = ta >= 0 ? 1.f : 0.f, fb = tb >= 0 ? 1.f : 0.f; const bool dg_ = (j == t) && ((c >> 3) == (cb & 1)); float o[8];
#pragma unroll
        for (int q = 0; q < 4; ++q) { o[q] = fa * a0[q] + fb * b0[q]; o[4 + q] = fa * a1[q] + fb * b1[q]; }
#pragma unroll
        for (int q = 0; q < 8; ++q) o[q] += (dg_ && q == (c & 7)) ? d : 0.f;
        u32x4 w; w.x = cvt_pk_bf16(o[0], o[1]); w.y = cvt_pk_bf16(o[2], o[3]); w.z = cvt_pk_bf16(o[4], o[5]); w.w = cvt_pk_bf16(o[6], o[7]);
        *(u32x4*)(TQ + ((size_t)g * 512 + row) * UK + cb * 8) = w; }
#pragma unroll 2
    for (int i = gt; i < SG * 512 * 32; i += NT_) { const int cbb = i & 31, row = (i >> 5) & 511, g = i >> 14; const int t = row >> 4, c = row & 15; float o[8];
        const int dir = cbb >> 4, n0 = (cbb & 15) * 4; const int dg = dir * SG + g; const int tau = dir == 0 ? t + 1 : SL - t;
#pragma unroll
        for (int q = 0; q < 4; ++q) { const int n = n0 + q; const float2 a = APOW[((size_t)dg * SN + n) * (SL + 1) + tau];
            const float cr = F.a->in[27][((size_t)dg * SC + c) * SN + n], ci = F.a->in[28][((size_t)dg * SC + c) * SN + n];
            o[2 * q] = cr * a.x - ci * a.y; o[2 * q + 1] = -(cr * a.y + ci * a.x); }
        u32x4 w; w.x = cvt_pk_bf16(o[0], o[1]); w.y = cvt_pk_bf16(o[2], o[3]); w.z = cvt_pk_bf16(o[4], o[5]); w.w = cvt_pk_bf16(o[6], o[7]);
        *(u32x4*)(TQ + ((size_t)g * 512 + row) * UK + (64 + cbb) * 8) = w; }
    for (int i = gt; i < SG * 256 * 64; i += NT_) { const int cb = i & 63, row = (i >> 6) & 255, g = i >> 14; const int dir = row >> 7, n = (row >> 1) & 63, im = row & 1; const int dg = dir * SG + g;
        const int j = cb >> 1, cp0 = (cb & 1) * 8; const int tau = dir == 0 ? SL - 1 - j : j; const float2 a = APOW[((size_t)dg * SN + n) * (SL + 1) + tau]; float o[8];
#pragma unroll
        for (int q = 0; q < 8; ++q) { const float2 bb = BBAR[((size_t)dg * SN + n) * SC + cp0 + q]; o[q] = im ? (a.x * bb.y + a.y * bb.x) : (a.x * bb.x - a.y * bb.y); }
        u32x4 w; w.x = cvt_pk_bf16(o[0], o[1]); w.y = cvt_pk_bf16(o[2], o[3]); w.z = cvt_pk_bf16(o[4], o[5]); w.w = cvt_pk_bf16(o[6], o[7]);
        *(u32x4*)(POP + ((size_t)g * 256 + row) * 512 + cb * 8) = w; }
}
__device__ __forceinline__ void phase_scan(Frame& F) {
    const float2* APOW = (const float2*)(F.ws + WS_APOW); const float* SLOC = (const float*)(F.ws + WS_SLOC); bf16_t* U = (bf16_t*)(F.ws + WS_U);
    if (F.tid >= 256) return;
    for (int i = blockIdx.x * 256 + F.tid; i < NB * SG * 2 * SN; i += F.G * 256) { const int n = i & 63, dir = (i >> 6) & 1, g = (i >> 7) & 63, b = i >> 13;
        const float2 aL = APOW[(((size_t)dir * SG + g) * SN + n) * (SL + 1) + SL];
        const float* sl = SLOC + (size_t)g * UROWS * 256 + dir * 128 + 2 * n; bf16_t* ub = U + (size_t)g * UROWS * UK + 512 + dir * 128 + 2 * n;
        float sr = 0.f, si = 0.f; f32x2 v[32];
#pragma unroll
        for (int q = 0; q < 8; ++q) { const int k = dir == 0 ? q : NCHC - 1 - q; v[q] = *(const f32x2*)(sl + (size_t)(1024 + b * NCHC + k) * 256); }
#pragma unroll
        for (int q = 0; q < 8; ++q) { const float nr = aL.x * sr - aL.y * si + v[q].x, ni = aL.x * si + aL.y * sr + v[q].y; sr = nr; si = ni; }
        for (int k0 = 0; k0 < NCHL; k0 += 32) {
#pragma unroll
            for (int q = 0; q < 32; ++q) { const int k = dir == 0 ? k0 + q : NCHL - 1 - k0 - q; v[q] = *(const f32x2*)(sl + (size_t)(b * NCHL + k) * 256); }
#pragma unroll
            for (int q = 0; q < 32; ++q) { const int k = dir == 0 ? k0 + q : NCHL - 1 - k0 - q; *(unsigned*)(ub + (size_t)(b * NCHL + k) * UK) = cvt_pk_bf16(sr, si);
                const float nr = aL.x * sr - aL.y * si + v[q].x, ni = aL.x * si + aL.y * sr + v[q].y; sr = nr; si = ni; }
        }
    }
}
constexpr int N_PHASES = 23;
__global__ void __launch_bounds__(NTHR, 2) mega_fwd(Args args) {
    extern __shared__ __attribute__((aligned(16))) unsigned char lds_raw[];
    Frame F;
    F.lds = (LAS unsigned char*)lds_raw; F.ldsg = lds_raw;
    F.tid = threadIdx.x; F.lane = F.tid & 63; F.wave = __builtin_amdgcn_readfirstlane(F.tid >> 6);
    F.G = gridDim.x; { const int bx = blockIdx.x; F.vcu = (F.G % 8 == 0) ? (bx % 8) * (F.G / 8) + bx / 8 : bx; }
    F.gw = blockIdx.x * NWAVES + F.wave; F.ngw = F.G * NWAVES;
    F.ws = args.ws; F.out = args.out;
    F.a = &args;
    volatile LAS unsigned* MISC = (volatile LAS unsigned*)(F.lds + MISC_OFF);
    for (int u = F.tid; u < (LDS_BYTES - RING_BYTES) / 4; u += NTHR) ((LAS unsigned*)(F.lds + RING_BYTES))[u] = 0u;
    __syncthreads();
    const int lo = args.ph_lo, hi = args.ph_hi;
    const bool multi = (hi - lo) > 1;
    XcdBarrier bar; bar.bar = (unsigned*)(F.ws + WS_CTL) + CW_BAR; bar.x = 0; bar.st = nullptr;
    if (multi) bar = xcd_barrier_post((unsigned*)(F.ws + WS_CTL) + CW_BAR, MISC + 8);
#define IN(k) (lo <= (k) && (k) < hi)
#define SEAM(k) do { if (IN(k) && IN((k) + 1)) xcd_barrier(bar); } while (0)
#ifndef DUP_MASK
#define DUP_MASK 0u

#endif
#define PHASE(k, ...) do { if (IN(k)) { __VA_ARGS__ if ((DUP_MASK >> (k)) & 1u) { xcd_barrier(bar); __VA_ARGS__ } } SEAM(k); } while (0)
    using namespace pg8;
    bf16_t* A1 = (bf16_t*)(F.ws + WS_A1); bf16_t* Zb = (bf16_t*)(F.ws + WS_Z); bf16_t* Y1 = (bf16_t*)(F.ws + WS_Y1);
    bf16_t* XS = (bf16_t*)(F.ws + WS_XS); unsigned char* HID = (unsigned char*)(F.ws + WS_HID); bf16_t* Ub = (bf16_t*)(F.ws + WS_U);
    bf16_t* ZG = (bf16_t*)(F.ws + WS_ZG); bf16_t* ZZ = (bf16_t*)(F.ws + WS_ZZ);
    float* MOD = (float*)(F.ws + WS_MOD);

    constexpr int PW_ATT = 16 * 64 + 8 * 32, PW_ALL = PW_ATT + 3 * 16 * 32;
    const bool split0 = (F.G == 256);
    PHASE(0, { if (split0) { p0_mod(F, 0, 1, 0, 96); p0_tables(F, 96, 16); p0_poolfold(F, 1024, 1024); p0_weights(F, 0, PW_ATT, 96 * 8, 160 * 8); }
               else { p0_mod(F, 0, 2, 0, F.G); p0_tables(F, 0, F.G); p0_poolfold(F, 0, F.ngw); p0_weights(F, 0, PW_ALL, 0, F.ngw); } });
    PHASE(1, { phase_norm1_l0(F); p1_ktab(F); });
    PHASE(2, { Gemm g{A1, (const bf16_t*)(F.ws + WS_WIN), 1024, 1024, 1024, 0, 0}; OrdDense S; S.init(NTOK / 256, 8, F.G, (int)blockIdx.x);
        EpiInProj E{Zb, (const float*)(F.ws + WS_ROPE), (const float*)(F.ws + WS_ROPE) + 128 * 16};
        gemm_phase<EpiInProj, OrdDense>(F.lds, g, S, E); p2_operators(F); });
    PHASE(3, { phase_attn(F); });
    PHASE(4, { Gemm g{Y1, (const bf16_t*)(F.ws + WS_WOUT), 1024, 1024, 1024, 0, 0}; OrdDense S; S.init(NTOK / 256, 4, F.G, (int)blockIdx.x);
        EpiResid E{F.a->in[0], F.a->in[2], (bf16_t*)(F.ws + WS_HB), MOD, 1};
        gemm_phase<EpiResid, OrdDense>(F.lds, g, S, E);
        if (split0) { __syncthreads(); p0_mod(F, 1, 2, 160, 96); p0_weights(F, PW_ATT, PW_ALL, 16 * 8, 240 * 8); } });
    PHASE(5, { phase_norm2_router(F, 0, true); });
    PHASE(6, { phase_select(F, true); });
    PHASE(8, { Gemm g{A1, (const bf16_t*)(F.ws + WS_GU), 1024, 1024, 1024, 0, (size_t)4096 * 1024}; OrdGrouped S; S.init(16, 16, 16, 1, F.G, F.vcu);
        EpiGateUp E{HID, 1.0f}; gemm_phase_f8<EpiGateUp, OrdGrouped, true>(F.lds, g, S, E, (const int*)(F.ws + WS_TOK), XROWS, NTOK); });
    PHASE(9, { Gemm g{(const bf16_t*)HID, (const bf16_t*)(F.ws + WS_DN), 2048, 2048, 2048, (size_t)XROWS * 2048, (size_t)1024 * 2048}; OrdGrouped S; S.init(16, 16, 4, 1, F.G, F.vcu);
        EpiF8Out E{(unsigned char*)XS, 1024, (size_t)XROWS * 1024}; gemm_phase_f8<EpiF8Out, OrdGrouped>(F.lds, g, S, E); });
#ifdef PROBE_P10
    if (IN(10)) { phase_combine(F, 0, true, 0, true); xcd_barrier(bar); }
#endif
    PHASE(10, { phase_combine(F, 0, true, 0); });
    PHASE(11, { Gemm g{A1, (const bf16_t*)(F.ws + WS_SWIN), 1024, 1024, 1024, 0, 0}; OrdDense S; S.init(NTOK / 256, 4, F.G, (int)blockIdx.x);
        EpiSsmIn E{Ub}; gemm_phase_f8<EpiSsmIn, OrdDense>(F.lds, g, S, E); });
    PHASE(12, { Gemm g{Ub, (const bf16_t*)(F.ws + WS_POP), UK, 512, 512, (size_t)UROWS * UK, (size_t)256 * 512}; OrdGrouped S; S.init(64, 5, 1, 0, F.G, F.vcu);
        EpiF32 E{(float*)(F.ws + WS_SLOC), 256, (size_t)UROWS * 256}; gemm_phase<EpiF32, OrdGrouped>(F.lds, g, S, E); });
    PHASE(13, { phase_scan(F); });
    PHASE(14, { Gemm g{Ub, (const bf16_t*)(F.ws + WS_TQ), UK, UK, UK, (size_t)UROWS * UK, (size_t)512 * UK}; OrdGrouped S; S.init(64, 4, 2, 0, F.G, F.vcu);
        EpiSsmY E{ZG}; gemm_phase<EpiSsmY, OrdGrouped>(F.lds, g, S, E); });
    PHASE(15, { Gemm g{ZG, (const bf16_t*)(F.ws + WS_SWGLU), 1024, 1024, 1024, 0, 0}; OrdDense S; S.init(NLAT / 256, 4, F.G, (int)blockIdx.x);
        EpiGlu E{ZG, ZZ}; gemm_phase<EpiGlu, OrdDense>(F.lds, g, S, E); });
    PHASE(16, { Gemm g{ZZ, (const bf16_t*)(F.ws + WS_SWOUT), 1024, 1024, 1024, 0, 0}; OrdDense S; S.init(NLAT / 256, 4, F.G, (int)blockIdx.x);
        EpiResid E{nullptr, nullptr, (bf16_t*)(F.ws + WS_HB), MOD + 5 * 6144, 0}; gemm_phase<EpiResid, OrdDense>(F.lds, g, S, E); });
    PHASE(17, { phase_norm2_router(F, 1, false); });
    PHASE(18, { phase_select(F, false); });
    PHASE(20, { Gemm g{A1, (const bf16_t*)(F.ws + WS_GU + (size_t)16 * 4096 * 1024), 1024, 1024, 1024, 0, (size_t)4096 * 1024}; OrdGrouped S; S.init(16, 16, 16, 0, F.G, F.vcu);
        EpiGateUp E{HID, 1.0f}; gemm_phase_f8<EpiGateUp, OrdGrouped, true>(F.lds, g, S, E, (const int*)(F.ws + WS_TOK), XROWS, NTOK); });
    PHASE(21, { Gemm g{(const bf16_t*)HID, (const bf16_t*)(F.ws + WS_DN + (size_t)16 * 1024 * 2048), 2048, 2048, 2048, (size_t)XROWS * 2048, (size_t)1024 * 2048}; OrdGrouped S; S.init(16, 16, 4, 0, F.G, F.vcu);
        EpiF8Out E{(unsigned char*)XS, 1024, (size_t)XROWS * 1024}; gemm_phase_f8<EpiF8Out, OrdGrouped>(F.lds, g, S, E); });
#ifdef PROBE_P22
    if (IN(22)) { phase_combine(F, 1, false, 1, true); xcd_barrier(bar); }
#endif
    PHASE(22, { phase_combine(F, 1, false, 1); });
#undef IN
#undef SEAM
}

#ifndef MK_ONE_LAUNCH
#define MK_ONE_LAUNCH 1
#endif
extern "C" void kernel_launch(void* const* d_in, const int* in_sizes, int n_in, void* d_out, int out_size, void* d_ws, size_t ws_size, hipStream_t stream) {
    static int grid = 0;
    if (grid == 0) {
        if (n_in != 33 || out_size != NLAT * DM || ws_size < WS_END) { fprintf(stderr, "kernel_launch: unexpected shapes: n_in %d out %d ws %zu (need %zu)\n", n_in, out_size, ws_size, (size_t)WS_END); grid = -1; return; }
        int dev = 0, cus = 0;
        if (hipGetDevice(&dev) != hipSuccess || hipDeviceGetAttribute(&cus, hipDeviceAttributeMultiprocessorCount, dev) != hipSuccess) { grid = -1; return; }
        if (hipFuncSetAttribute((const void*)mega_fwd, hipFuncAttributeMaxDynamicSharedMemorySize, LDS_BYTES) != hipSuccess) { fprintf(stderr, "kernel_launch: hipFuncSetAttribute failed\n"); grid = -1; return; }
        int per_cu = 0; (void)hipOccupancyMaxActiveBlocksPerMultiprocessor(&per_cu, (const void*)mega_fwd, NTHR, LDS_BYTES); (void)hipGetLastError();
        if (per_cu < 1) fprintf(stderr, "kernel_launch: occupancy query reports %d blocks per CU\n", per_cu);
        grid = cus;
    }
    if (grid < 0) return;
    (void)hipMemsetAsync((char*)d_ws + WS_CTL, 0, CTL_ZERO_BYTES, stream);
    Args a{};
    for (int i = 0; i < 33; ++i) a.in[i] = (const float*)d_in[i];
    a.out = (float*)d_out; a.ws = (unsigned char*)d_ws;
#if MK_ONE_LAUNCH
    a.ph_lo = 0; a.ph_hi = N_PHASES;
    hipLaunchKernelGGL(mega_fwd, dim3(grid), dim3(NTHR), LDS_BYTES, stream, a);
#else
    for (int p = 0; p < N_PHASES; ++p) { a.ph_lo = p; a.ph_hi = p + 1; hipLaunchKernelGGL(mega_fwd, dim3(grid), dim3(NTHR), LDS_BYTES, stream, a); }
#endif
}
```

```cpp
#include <hip/hip_runtime.h>
#include <cstdio>
#include <cstdint>

#define LAS __attribute__((address_space(3)))
#define GAS __attribute__((address_space(1)))
typedef unsigned short bf16_t;
typedef short bf16x8 __attribute__((ext_vector_type(8)));
typedef short s16x4 __attribute__((ext_vector_type(4)));
typedef float f32x2 __attribute__((ext_vector_type(2)));
typedef float f32x4 __attribute__((ext_vector_type(4)));
typedef float f32x16 __attribute__((ext_vector_type(16)));
typedef unsigned u32x2 __attribute__((ext_vector_type(2)));
typedef unsigned u32x4 __attribute__((ext_vector_type(4)));

constexpr int NB = 4, SEQ = 8192, DM = 1024, CTXL = 256;
constexpr int SP = SEQ + CTXL;
constexpr int NTOK = NB * SP;
constexpr int NLAT = NB * SEQ;
constexpr int NEXP = 16, EHID = 2048, CAPL = 1024, CAPC = 32;
constexpr int XROWS = 4352;
constexpr int SG = 64, SN = 64, SC = 16, SL = 32;
constexpr int NCHL = SEQ / SL, NCHC = CTXL / SL;
constexpr int UROWS = 1280, UK = 768;
constexpr float EPSN = 1e-6f;

constexpr size_t MiB = 1u << 20;
constexpr size_t WS_CTL = 0, CTL_ZERO_BYTES = 1 * MiB;
constexpr size_t WS_MOD = 1 * MiB;
constexpr size_t WS_ROPE = 1 * MiB + 256 * 1024;
constexpr size_t WS_LAM = 1 * MiB + 320 * 1024;
constexpr size_t WS_APOW = 2 * MiB;
constexpr size_t WS_BBAR = 5 * MiB;
constexpr size_t WS_KTAB = 6 * MiB;
constexpr size_t WS_AFF = 10 * MiB;
constexpr size_t WS_AFFC = 12 * MiB;
constexpr size_t WS_SLOT = 13 * MiB;
constexpr size_t WS_SLOTC = 15 * MiB;
constexpr size_t WS_TOK = 15 * MiB + 512 * 1024;
constexpr size_t WS_HC = 16 * MiB;
constexpr size_t WS_HB = 954 * MiB;
constexpr size_t WS_WIN = 20 * MiB;
constexpr size_t WS_WOUT = 24 * MiB;
constexpr size_t WS_SWIN = 26 * MiB, WS_SWGLU = 28 * MiB, WS_SWOUT = 30 * MiB;
constexpr size_t WS_TQ = 32 * MiB;
constexpr size_t WS_POP = 80 * MiB;
constexpr size_t WS_GU = 96 * MiB;
constexpr size_t WS_DN = 352 * MiB;
constexpr size_t WS_A1 = 480 * MiB;
constexpr size_t WS_Z = 546 * MiB;
constexpr size_t WS_Y1 = 678 * MiB;
constexpr size_t WS_XS = 546 * MiB;
constexpr size_t WS_HID = 682 * MiB;
constexpr size_t WS_U = 546 * MiB;
constexpr size_t WS_SLOC = 666 * MiB;
constexpr size_t WS_ZG = 746 * MiB;
constexpr size_t WS_ZZ = 810 * MiB;
constexpr size_t WS_END = 1020 * MiB;
static_assert(WS_A1 + (size_t)NTOK * DM * 2 <= WS_Z && WS_Z + (size_t)NTOK * 2048 * 2 <= WS_Y1 && WS_XS + (size_t)16 * XROWS * 1024 * 2 <= WS_HID &&
              WS_HID + (size_t)16 * XROWS * 2048 * 2 <= WS_END && WS_U + (size_t)64 * UROWS * UK * 2 <= WS_SLOC && WS_SLOC + (size_t)64 * UROWS * 256 * 4 <= WS_ZG &&
              WS_ZG + (size_t)NLAT * DM * 2 <= WS_ZZ && WS_ZZ + (size_t)NLAT * DM * 2 <= WS_END && WS_Y1 + (size_t)NTOK * DM * 2 <= WS_END, "ws map");
static_assert(WS_GU + (size_t)2 * 16 * 4096 * 1024 * 2 <= WS_DN && WS_DN + (size_t)2 * 16 * 1024 * 2048 * 2 <= WS_A1 && WS_TQ + (size_t)64 * 512 * 768 * 2 <= WS_POP && WS_POP + (size_t)64 * 256 * 512 * 2 <= WS_GU, "ws map 2");
static_assert(WS_APOW + (size_t)2 * 64 * 64 * 33 * 8 <= WS_BBAR && WS_BBAR + (size_t)2 * 64 * 64 * 16 * 8 <= WS_KTAB && WS_KTAB + (size_t)2 * 64 * 32 * 256 * 4 <= WS_AFF, "ws map 3");
constexpr int CW_BAR = 4096;

constexpr int RING_BYTES = 131072;
constexpr int MISC_OFF = 147456 - 256;
constexpr int LDS_BYTES = 147456;
constexpr int NWAVES = 8, NTHR = 512;

typedef __bf16 bf16x2_t __attribute__((ext_vector_type(2)));
__device__ __forceinline__ unsigned cvt_pk_bf16(float lo, float hi) { const bf16x2_t r = __builtin_convertvector((f32x2){lo, hi}, bf16x2_t); return __builtin_bit_cast(unsigned, r); }
__device__ __forceinline__ float bf2f(unsigned short b) { return __uint_as_float(((unsigned)b) << 16); }
__device__ __forceinline__ float bflo(unsigned w) { return __uint_as_float(w << 16); }
__device__ __forceinline__ float bfhi(unsigned w) { return __uint_as_float(w & 0xffff0000u); }
#define DPP_I(x, ctrl) __builtin_amdgcn_update_dpp(0, (x), (ctrl), 0xF, 0xF, true)
__device__ __forceinline__ float dpp_f(float v, const int ctrl_unused) { (void)ctrl_unused; return v; }
__device__ __forceinline__ float row16_sum(float v) {
    v += __builtin_bit_cast(float, DPP_I(__builtin_bit_cast(int, v), 0xB1));
    v += __builtin_bit_cast(float, DPP_I(__builtin_bit_cast(int, v), 0x4E));
    v += __builtin_bit_cast(float, DPP_I(__builtin_bit_cast(int, v), 0x141));
    v += __builtin_bit_cast(float, DPP_I(__builtin_bit_cast(int, v), 0x140));
    return v;
}
__device__ __forceinline__ float half32_sum(float v) {
    v = row16_sum(v);
    const auto r = __builtin_amdgcn_permlane16_swap(__float_as_uint(v), __float_as_uint(v), false, false);
    return __uint_as_float(r[0]) + __uint_as_float(r[1]);
}
__device__ __forceinline__ float wave_sum(float v) {
    v = half32_sum(v);
    const auto r = __builtin_amdgcn_permlane32_swap(__float_as_uint(v), __float_as_uint(v), false, false);
    return __uint_as_float(r[0]) + __uint_as_float(r[1]);
}
__device__ __forceinline__ int wave_sum_i(int v) {
    v += DPP_I(v, 0xB1); v += DPP_I(v, 0x4E); v += DPP_I(v, 0x141); v += DPP_I(v, 0x140);
    { const auto r = __builtin_amdgcn_permlane16_swap((unsigned)v, (unsigned)v, false, false); v = (int)(r[0] + r[1]); }
    { const auto r = __builtin_amdgcn_permlane32_swap((unsigned)v, (unsigned)v, false, false); v = (int)(r[0] + r[1]); }
    return v;
}
__device__ __forceinline__ float wave_max(float v) {
    v = fmaxf(v, __builtin_bit_cast(float, DPP_I(__builtin_bit_cast(int, v), 0xB1))); v = fmaxf(v, __builtin_bit_cast(float, DPP_I(__builtin_bit_cast(int, v), 0x4E)));
    v = fmaxf(v, __builtin_bit_cast(float, DPP_I(__builtin_bit_cast(int, v), 0x141))); v = fmaxf(v, __builtin_bit_cast(float, DPP_I(__builtin_bit_cast(int, v), 0x140)));
    { const auto r = __builtin_amdgcn_permlane16_swap(__float_as_uint(v), __float_as_uint(v), false, false); v = fmaxf(__uint_as_float(r[0]), __uint_as_float(r[1])); }
    { const auto r = __builtin_amdgcn_permlane32_swap(__float_as_uint(v), __float_as_uint(v), false, false); v = fmaxf(__uint_as_float(r[0]), __uint_as_float(r[1])); }
    return v;
}
__device__ __forceinline__ float reduce_scatter16(float (&a)[16], int lane) {
    float s8[8], t4[4], u2[2];
#pragma unroll
    for (int e = 0; e < 8; ++e) { const auto r = __builtin_amdgcn_permlane32_swap(__float_as_uint(a[e]), __float_as_uint(a[e + 8]), false, false); s8[e] = __uint_as_float(r[0]) + __uint_as_float(r[1]); }
#pragma unroll
    for (int e = 0; e < 4; ++e) { const auto r = __builtin_amdgcn_permlane16_swap(__float_as_uint(s8[e]), __float_as_uint(s8[e + 4]), false, false); t4[e] = __uint_as_float(r[0]) + __uint_as_float(r[1]); }
    const bool b3 = (lane & 8) != 0, b2 = (lane & 4) != 0;
#pragma unroll
    for (int e = 0; e < 2; ++e) { const float keep = b3 ? t4[e + 2] : t4[e], give = b3 ? t4[e] : t4[e + 2];
        u2[e] = keep + __builtin_bit_cast(float, DPP_I(__builtin_bit_cast(int, give), 0x140)); }
    const float keep = b2 ? u2[1] : u2[0], give = b2 ? u2[0] : u2[1];
    float w = keep + __builtin_bit_cast(float, DPP_I(__builtin_bit_cast(int, give), 0x141));
    w += __builtin_bit_cast(float, DPP_I(__builtin_bit_cast(int, w), 0xB1)); w += __builtin_bit_cast(float, DPP_I(__builtin_bit_cast(int, w), 0x4E));
    return w;
}
__device__ __forceinline__ float sigmoidf_(float x) { return __builtin_amdgcn_rcpf(1.0f + __expf(-x)); }
__device__ __forceinline__ float siluf_(float x) { return x * __builtin_amdgcn_rcpf(1.0f + __expf(-x)); }
__device__ __forceinline__ float gelu_tanh_(float x) {
    const float u = 1.5957691216057308f * (x + 0.044715f * x * x * x);
    return x * __builtin_amdgcn_rcpf(1.0f + __expf(-u));
}
__device__ __forceinline__ unsigned pk4_fp8(float a, float b, float c, float d) { int t = __builtin_amdgcn_cvt_pk_fp8_f32(a, b, 0, false); t = __builtin_amdgcn_cvt_pk_fp8_f32(c, d, t, true); return (unsigned)t; }
#define LDS_WAIT() asm volatile("s_waitcnt lgkmcnt(0)" ::: "memory")
#define VM_WAIT() asm volatile("s_waitcnt vmcnt(0)" ::: "memory")

#define XB_TMO      128
#define XB_XCNT(j)  (256  + 64 * (j))
#define XB_XSUB(j)  (1280 + 64 * (j))
#define XB_XGEN(j)  (2304 + 64 * (j))
#define XB_TOP      3328
#define XB_TOPGEN   3392
#define XCD_BAR_WORDS 3456
#define XB_SPIN_CAP (1u << 18)
__device__ __forceinline__ unsigned xb_ld(unsigned* p)              { return __hip_atomic_load(p, __ATOMIC_RELAXED, __HIP_MEMORY_SCOPE_AGENT); }
__device__ __forceinline__ unsigned xb_add(unsigned* p, unsigned v) { return __hip_atomic_fetch_add(p, v, __ATOMIC_RELAXED, __HIP_MEMORY_SCOPE_AGENT); }
__device__ __forceinline__ unsigned xb_xcc_id() { return (unsigned)__builtin_amdgcn_s_getreg((3 << 11) | 20) & 0xFu; }
#define XB_SPIN(cond, bar) do { unsigned _sp = 0; while (cond) { __builtin_amdgcn_s_sleep(1); \
    if ((++_sp & 255u) == 0u) { if (xb_ld(&(bar)[XB_TMO])) break; if (_sp > XB_SPIN_CAP) { atomicAdd(&(bar)[XB_TMO], 1u); break; } } } } while (0)
struct XcdBarrier { unsigned* bar; unsigned x; volatile LAS unsigned* st; };
__device__ __forceinline__ XcdBarrier xcd_barrier_post(unsigned* bar, volatile LAS unsigned* st) {
    XcdBarrier b; b.bar = bar; b.x = xb_xcc_id(); b.st = st;
    if (threadIdx.x == 0) (void)xb_add(&bar[XB_XCNT(b.x)], 1u);
    return b;
}
__device__ __forceinline__ void xcd_barrier_complete(unsigned* bar, unsigned x, unsigned& nloc, unsigned& nx) {
    const unsigned G = gridDim.x * gridDim.y * gridDim.z;
    unsigned sum, cnt, mine, sp = 0u;
    for (;;) {
        sum = 0u; cnt = 0u; mine = 0u;
#pragma unroll
        for (unsigned j = 0; j < 16; ++j) { const unsigned c = xb_ld(&bar[XB_XCNT(j)]); sum += c; cnt += (c > 0u) ? 1u : 0u; mine = (j == x) ? c : mine; }
        if (sum == G) break;
        __builtin_amdgcn_s_sleep(1);
        if ((++sp & 255u) == 0u) { if (xb_ld(&bar[XB_TMO])) break; if (sp > XB_SPIN_CAP) { atomicAdd(&bar[XB_TMO], 1u); break; } }
    }
    nloc = mine > 0u ? mine : 1u; nx = cnt > 0u ? cnt : 1u;
}
__device__ __forceinline__ void xcd_barrier(const XcdBarrier& b) {
    asm volatile("s_waitcnt vmcnt(0)" ::: "memory");
    __syncthreads();
    if (threadIdx.x == 0) {
        unsigned* bar = b.bar;
        __builtin_amdgcn_s_waitcnt(0);
        unsigned nloc = b.st[0], nx = b.st[1];
        if (nloc == 0u) { xcd_barrier_complete(bar, b.x, nloc, nx); b.st[0] = nloc; b.st[1] = nx; }
        const unsigned old = xb_add(&bar[XB_XSUB(b.x)], 1u);
        const unsigned gen = old / nloc;
        if (old + 1u == (gen + 1u) * nloc) {
            __builtin_amdgcn_fence(__ATOMIC_RELEASE, "agent");
            asm volatile("s_waitcnt vmcnt(0)" ::: "memory");
            const unsigned og = xb_add(&bar[XB_TOP], 1u);
            const unsigned tg = og / nx;
            if (og + 1u == (tg + 1u) * nx) xb_add(&bar[XB_TOPGEN], 1u);
            else XB_SPIN(xb_ld(&bar[XB_TOPGEN]) == tg, bar);
            __builtin_amdgcn_fence(__ATOMIC_ACQUIRE, "agent");
            xb_add(&bar[XB_XGEN(b.x)], 1u);
            asm volatile("s_waitcnt vmcnt(0)" ::: "memory");
        } else {
            XB_SPIN(xb_ld(&bar[XB_XGEN(b.x)]) == gen, bar);
            __builtin_amdgcn_fence(__ATOMIC_ACQUIRE, "agent");
            asm volatile("s_waitcnt vmcnt(0)" ::: "memory");
        }
    }
    __syncthreads();
}
namespace pg8 {
constexpr int BM = 256, BK = 64, HALF = 128, HTB = HALF * BK * 2, STAGE_BYTES = 8 * HTB, NXCD = 8, WGM = 8;
__host__ __device__ __forceinline__ int lds_byte(int r, int c) { const int st = (r >> 4) * 2 + (c >> 5), rr = r & 15, cc = c & 31, ob = rr * 64 + cc * 2; return st * 1024 + (ob ^ (((ob >> 9) & 1) << 5)); }
__host__ __device__ __forceinline__ void stage_rc(int b, int& R, int& C) { const int st = b / 1024, sb = b % 1024, swz = sb ^ (((sb >> 9) & 1) << 5); R = (st >> 1) * 16 + swz / 64; C = (st & 1) * 32 + (swz % 64) / 2; }
__host__ __device__ __forceinline__ int perm32(int rho) { const int n = rho >> 4, i = rho & 15; return 8 * (i >> 2) + 4 * n + (i & 3); }

struct Unit { int pm, pn, g; };
struct Gemm { const bf16_t* A; const bf16_t* Bt; int lda, ldb, K; size_t gsA, gsB; };

struct OrdDense {
    int nM, nN, nwg, G, c;
    __device__ void init(int nM_, int nN_, int G_, int c_) { nM = nM_; nN = nN_; nwg = nM * nN; G = G_; c = c_; }
    __device__ bool next(int i, Unit& u) const {
        const long L = (long)i * G + c; if (L >= nwg) return false;
        int wgid = (int)L; { const int q = nwg / NXCD, r = nwg % NXCD, xcd = wgid % NXCD, off = wgid / NXCD; wgid = (xcd < r ? xcd * (q + 1) : r * (q + 1) + (xcd - r) * q) + off; }
        const int nig = WGM * nN, gid = wgid / nig, fm = gid * WGM, gsz = (nM - fm) < WGM ? (nM - fm) : WGM;
        u.pm = fm + ((wgid % nig) % gsz); u.pn = (wgid % nig) / gsz; u.g = 0; return true;
    }
};
struct OrdGrouped {
    int ng, nM, nN, nX, G, v;
    __device__ void init(int ng_, int nM_, int nN_, int nX_, int G_, int v_) { ng = ng_; nM = nM_; nN = nN_; nX = nX_; G = G_; v = v_; }
    __device__ bool next(int i, Unit& u) const {
        const int per = nM * nN, main = ng * per; const long L = (long)i * G + v;
        if (L < main) { const int l = (int)L; u.g = l / per; const int rem = l % per; u.pn = rem % nN; u.pm = rem / nN; return true; }
        const int l2 = (int)(L - main); if (l2 >= ng * nN * nX) return false;
        u.g = l2 / nN; u.pn = l2 % nN; u.pm = nM; return true;
    }
};

template <class Epi, class Sched>
__device__ __forceinline__ void gemm_phase(LAS unsigned char* lds, const Gemm g, const Sched& S, const Epi& E) {
    const int tid = threadIdx.x, wid = __builtin_amdgcn_readfirstlane(tid >> 6), lane = tid & 63, wr = wid >> 2, wc = wid & 3, fr = lane & 15, fq = lane >> 4;
    const int K = g.K, nt = K / BK;
    unsigned voffA[2], voffB[2];
#pragma unroll
    for (int i = 0; i < 2; ++i) { int R, C; stage_rc(tid * 16 + i * 8192, R, C); const int Rb = Epi::PERM ? ((R & ~31) + perm32(R & 31)) : R;
        voffA[i] = (unsigned)(R * g.lda + C) * 2u; voffB[i] = (unsigned)(Rb * g.ldb + C) * 2u; }
    const size_t kstep = (size_t)(BK * 2);
    const size_t hsA = (size_t)HALF * g.lda * 2, hsB = (size_t)HALF * g.ldb * 2;
    const unsigned ldsw = (unsigned)wid * 1024u;
    const int aoff = lds_byte(wr * 64 + fr, fq * 8), boff = lds_byte(wc * 32 + fr, fq * 8);
#define PG8_SA(b, h) (((b) * 2 + (h)) * HTB)
#define PG8_SB(b, h) ((4 + (b) * 2 + (h)) * HTB)
#define PG8_STAGE(bufoff, gbase, voff) do { _Pragma("unroll") for (int _i = 0; _i < 2; ++_i) \
        __builtin_amdgcn_global_load_lds((const unsigned*)((const char*)(gbase) + (voff)[_i]), (LAS unsigned*)(lds + (bufoff) + ldsw + _i * 8192), 16, 0, 0); } while (0)
#define PG8_LDA(dst, b, h) do { _Pragma("unroll") for (int m = 0; m < 4; ++m) _Pragma("unroll") for (int k = 0; k < 2; ++k) dst[m][k] = *(const LAS bf16x8*)(lds + PG8_SA(b, h) + aoff + m * 2048 + k * 1024); } while (0)
#define PG8_LDB(dst, b, h) do { _Pragma("unroll") for (int n = 0; n < 2; ++n) _Pragma("unroll") for (int k = 0; k < 2; ++k) dst[n][k] = *(const LAS bf16x8*)(lds + PG8_SB(b, h) + boff + n * 2048 + k * 1024); } while (0)
#define PG8_MMA(ai, bj, At, Bt) do { __builtin_amdgcn_s_setprio(1); _Pragma("unroll") for (int m = 0; m < 4; ++m) _Pragma("unroll") for (int n = 0; n < 2; ++n) _Pragma("unroll") for (int k = 0; k < 2; ++k) \
        acc[ai][bj][m][n] = __builtin_amdgcn_mfma_f32_16x16x32_bf16(Bt[n][k], At[m][k], acc[ai][bj][m][n], 0, 0, 0); __builtin_amdgcn_s_setprio(0); } while (0)
#define PG8_WAIT_V(n) asm volatile("s_waitcnt vmcnt(" #n ")" ::: "memory")
#define PG8_WAIT_L(n) asm volatile("s_waitcnt lgkmcnt(" #n ")" ::: "memory")
#define PG8_WAIT_V8F(fresh) do { if (fresh) { if constexpr (Epi::NST == 8) PG8_WAIT_V(16); else if constexpr (Epi::NST == 16) PG8_WAIT_V(24); else PG8_WAIT_V(40); } else PG8_WAIT_V(8); } while (0)
#define PG8_BAR __builtin_amdgcn_s_barrier()
#define PG8_SCHED __builtin_amdgcn_sched_barrier(0)
#define PG8_ABASE(u) ((const char*)g.A + ((size_t)(u).g * g.gsA + (size_t)(u).pm * BM * g.lda) * 2)
#define PG8_BBASE(u) ((const char*)g.Bt + ((size_t)(u).g * g.gsB + (size_t)(u).pn * BM * g.ldb) * 2)
    Unit cur, nxt; int ui = 0;
    if (!S.next(0, cur)) return;
    f32x4 acc[2][2][4][2];
#pragma unroll
    for (int a = 0; a < 2; ++a)
#pragma unroll
        for (int b = 0; b < 2; ++b)
#pragma unroll
            for (int m = 0; m < 4; ++m)
#pragma unroll
                for (int n = 0; n < 2; ++n) acc[a][b][m][n] = (f32x4){0.f, 0.f, 0.f, 0.f};
    bf16x8 At[4][2], B0[2][2], B1[2][2];
    const char* cA = PG8_ABASE(cur); const char* cB = PG8_BBASE(cur);
    PG8_STAGE(PG8_SB(0, 0), cB, voffB); PG8_STAGE(PG8_SB(0, 1), cB + hsB, voffB); PG8_STAGE(PG8_SA(0, 0), cA, voffA); PG8_STAGE(PG8_SA(0, 1), cA + hsA, voffA);
    if (wr == 1) PG8_BAR;
    PG8_WAIT_V(2); PG8_BAR;
    PG8_STAGE(PG8_SB(1, 0), cB + kstep, voffB); PG8_STAGE(PG8_SA(1, 0), cA + kstep, voffA); PG8_STAGE(PG8_SB(1, 1), cB + hsB + kstep, voffB);
    PG8_WAIT_V(6); PG8_BAR;
    for (;;) {
        const bool has_next = S.next(ui + 1, nxt);
        const char* nA = has_next ? PG8_ABASE(nxt) : cA; const char* nB = has_next ? PG8_BBASE(nxt) : cB;
#pragma clang loop unroll(disable)
        for (int t = 0; t < nt; t += 2) {
            const bool last = (t == nt - 2); const bool fresh = (t == 0) && (ui > 0);
            const char* a1 = cA + (size_t)(t + 1) * kstep;
            const char* a2 = last ? nA : cA + (size_t)(t + 2) * kstep; const char* b2 = last ? nB : cB + (size_t)(t + 2) * kstep;
            const char* a3 = a2 + kstep; const char* b3 = b2 + kstep;
            PG8_LDB(B0, 0, 0); PG8_LDB(B1, 0, 1); PG8_SCHED; PG8_LDA(At, 0, 0); PG8_STAGE(PG8_SA(1, 1), a1 + hsA, voffA);
            PG8_WAIT_V8F(fresh); PG8_WAIT_L(0); PG8_BAR; PG8_MMA(0, 0, At, B0); PG8_MMA(0, 1, At, B1); PG8_BAR; PG8_SCHED;
            PG8_LDA(At, 0, 1); PG8_STAGE(PG8_SB(0, 0), b2, voffB); PG8_STAGE(PG8_SB(0, 1), b2 + hsB, voffB); PG8_STAGE(PG8_SA(0, 0), a2, voffA);
            PG8_WAIT_V8F(fresh); PG8_WAIT_L(0); PG8_BAR; PG8_MMA(1, 0, At, B0); PG8_MMA(1, 1, At, B1); PG8_BAR; PG8_SCHED;
            PG8_LDB(B0, 1, 0); PG8_LDB(B1, 1, 1); PG8_SCHED; PG8_LDA(At, 1, 0); PG8_STAGE(PG8_SA(0, 1), a2 + hsA, voffA);
            PG8_WAIT_V(8); PG8_WAIT_L(0); PG8_BAR; PG8_MMA(0, 0, At, B0); PG8_MMA(0, 1, At, B1); PG8_BAR; PG8_SCHED;
            PG8_LDA(At, 1, 1); PG8_STAGE(PG8_SB(1, 0), b3, voffB); PG8_STAGE(PG8_SB(1, 1), b3 + hsB, voffB); PG8_STAGE(PG8_SA(1, 0), a3, voffA);
            PG8_WAIT_V(8); PG8_WAIT_L(0); PG8_BAR; PG8_MMA(1, 0, At, B0); PG8_MMA(1, 1, At, B1); PG8_BAR; PG8_SCHED;
        }
        if (wr == 0) PG8_BAR;
        E(acc, cur, wr, wc, fr, fq);
        if (!has_next) break;
#pragma unroll
        for (int a = 0; a < 2; ++a)
#pragma unroll
            for (int b = 0; b < 2; ++b)
#pragma unroll
                for (int m = 0; m < 4; ++m)
#pragma unroll
                    for (int n = 0; n < 2; ++n) acc[a][b][m][n] = (f32x4){0.f, 0.f, 0.f, 0.f};
        cur = nxt; cA = nA; cB = nB; ++ui;
        if (wr == 1) PG8_BAR;
    }
    PG8_WAIT_V(0);
    PG8_BAR;
#undef PG8_SA
#undef PG8_SB
#undef PG8_STAGE
#undef PG8_LDA
#undef PG8_LDB
#undef PG8_MMA
#undef PG8_WAIT_V
#undef PG8_WAIT_L
#undef PG8_WAIT_V8F
#undef PG8_BAR
#undef PG8_SCHED
#undef PG8_ABASE
#undef PG8_BBASE
}

typedef int i32x8 __attribute__((ext_vector_type(8)));
typedef int i32x4 __attribute__((ext_vector_type(4)));
template <class Epi, class Sched, bool GATHER = false>
__device__ __forceinline__ void gemm_phase_f8(LAS unsigned char* lds, const Gemm g, const Sched& S, const Epi& E, const int* tok = nullptr, int tok_gs = 0, int tok_max = 0) {
    const int tid = threadIdx.x, wid = __builtin_amdgcn_readfirstlane(tid >> 6), lane = tid & 63, wr = wid >> 2, wc = wid & 3, fr = lane & 15, fq = lane >> 4;
    const int K = g.K, nt = K / 128;
    unsigned voffA[2], voffB[2]; int rowA[2]; unsigned colA[2];
#pragma unroll
    for (int i = 0; i < 2; ++i) { int R, C; stage_rc(tid * 16 + i * 8192, R, C); const int Rb = Epi::PERM ? ((R & ~31) + perm32(R & 31)) : R;
        voffA[i] = (unsigned)(R * g.lda + C * 2); voffB[i] = (unsigned)(Rb * g.ldb + C * 2); rowA[i] = R; colA[i] = (unsigned)(C * 2); }
    const size_t kstep = (size_t)(BK * 2);
    const size_t hsA = (size_t)HALF * g.lda, hsB = (size_t)HALF * g.ldb;
    const unsigned ldsw = (unsigned)wid * 1024u;
    const int aoff = lds_byte(wr * 64 + fr, fq * 8), boff = lds_byte(wc * 32 + fr, fq * 8);
#define PG8_SA(b, h) (((b) * 2 + (h)) * HTB)
#define PG8_SB(b, h) ((4 + (b) * 2 + (h)) * HTB)
#define PG8_STAGE(bufoff, gbase, voff) do { _Pragma("unroll") for (int _i = 0; _i < 2; ++_i) \
        __builtin_amdgcn_global_load_lds((const unsigned*)((const char*)(gbase) + (voff)[_i]), (LAS unsigned*)(lds + (bufoff) + ldsw + _i * 8192), 16, 0, 0); } while (0)
#define PG8_LD32(p) __builtin_shufflevector(*(const LAS i32x4*)(p), *(const LAS i32x4*)((p) + 1024), 0, 1, 2, 3, 4, 5, 6, 7)
#define PG8_LDA(dst, b, h) do { _Pragma("unroll") for (int m = 0; m < 4; ++m) dst[m] = PG8_LD32(lds + PG8_SA(b, h) + aoff + m * 2048); } while (0)
#define PG8_LDB(dst, b, h) do { _Pragma("unroll") for (int n = 0; n < 2; ++n) dst[n] = PG8_LD32(lds + PG8_SB(b, h) + boff + n * 2048); } while (0)
#define PG8_MMA(ai, bj, At, Bt) do { __builtin_amdgcn_s_setprio(1); _Pragma("unroll") for (int m = 0; m < 4; ++m) _Pragma("unroll") for (int n = 0; n < 2; ++n) \
        asm volatile("v_mfma_scale_f32_16x16x128_f8f6f4 %0, %1, %2, %0, %3, %4 op_sel_hi:[0,0,0]" : "+v"(acc[ai][bj][m][n]) : "v"(Bt[n]), "v"(At[m]), "v"(sclw), "v"(scl)); __builtin_amdgcn_s_setprio(0); } while (0)
#define PG8_WAIT_V(n) asm volatile("s_waitcnt vmcnt(" #n ")" ::: "memory")
#define PG8_WAIT_L(n) asm volatile("s_waitcnt lgkmcnt(" #n ")" ::: "memory")
#define PG8_WAIT_V8F(fresh) do { if (fresh) { if constexpr (GATHER && Epi::NST == 8) PG8_WAIT_V(20);   else if constexpr (Epi::NST == 8) PG8_WAIT_V(16); else if constexpr (Epi::NST == 16) PG8_WAIT_V(24); else PG8_WAIT_V(40); } else PG8_WAIT_V(8); } while (0)
#define PG8_BAR __builtin_amdgcn_s_barrier()
#define PG8_SCHED __builtin_amdgcn_sched_barrier(0)
#define PG8_ABASE(u) ((const char*)g.A + ((size_t)(u).g * g.gsA + (size_t)(u).pm * BM * g.lda))
#define PG8_BBASE(u) ((const char*)g.Bt + ((size_t)(u).g * g.gsB + (size_t)(u).pn * BM * g.ldb))
#define PG8_GOFF(dst, u) do { _Pragma("unroll") for (int _h = 0; _h < 2; ++_h) _Pragma("unroll") for (int _i = 0; _i < 2; ++_i) { \
        int _t = tok[(size_t)(u).g * tok_gs + (u).pm * BM + _h * HALF + rowA[_i]]; _t = ((unsigned)_t < (unsigned)tok_max) ? _t : 0; dst[_h][_i] = (unsigned)_t * (unsigned)g.lda + colA[_i]; } } while (0)
    Unit cur, nxt; int ui = 0;
    if (!S.next(0, cur)) return;
    unsigned ogc[2][2], ogn[2][2];
    if constexpr (GATHER) { PG8_GOFF(ogc, cur); _Pragma("unroll") for (int _h = 0; _h < 2; ++_h) _Pragma("unroll") for (int _i = 0; _i < 2; ++_i) ogn[_h][_i] = ogc[_h][_i]; }
    f32x4 acc[2][2][4][2];
#pragma unroll
    for (int a = 0; a < 2; ++a)
#pragma unroll
        for (int b = 0; b < 2; ++b)
#pragma unroll
            for (int m = 0; m < 4; ++m)
#pragma unroll
                for (int n = 0; n < 2; ++n) { acc[a][b][m][n] = (f32x4){0.f, 0.f, 0.f, 0.f}; asm volatile("" : "+v"(acc[a][b][m][n])); }
    i32x8 At[4], B0[2], B1[2]; int scl = 0x7f7f7f7f, sclw = 0x7a7a7a7a; asm volatile("" : "+v"(scl), "+v"(sclw));
    const char* cA = GATHER ? (const char*)g.A : PG8_ABASE(cur); const char* cB = PG8_BBASE(cur);
    const __amdgpu_buffer_rsrc_t rsA = __builtin_amdgcn_make_buffer_rsrc((void*)g.A, 0, GATHER ? tok_max * g.lda : 0, 0x00020000);
#define PG8_STAGE_BUF(bufoff, kofs, voff) do { _Pragma("unroll") for (int _i = 0; _i < 2; ++_i) \
        __builtin_amdgcn_raw_ptr_buffer_load_lds(rsA, (LAS void*)(lds + (bufoff) + ldsw + _i * 8192), 16, (int)(voff)[_i], (int)(kofs), 0, 0); } while (0)
#define PG8_STA_C(buf, p, h) do { if constexpr (GATHER) PG8_STAGE_BUF(buf, (p) - cA, ogc[h]); else PG8_STAGE(buf, (p) + (h) * hsA, voffA); } while (0)
#define PG8_STA_X(buf, p, h) do { if constexpr (GATHER) PG8_STAGE_BUF(buf, (p) - cA, ogx[h]); else PG8_STAGE(buf, (p) + (h) * hsA, voffA); } while (0)
    PG8_STAGE(PG8_SB(0, 0), cB, voffB); PG8_STAGE(PG8_SB(0, 1), cB + hsB, voffB); PG8_STA_C(PG8_SA(0, 0), cA, 0); PG8_STA_C(PG8_SA(0, 1), cA, 1);
    if (wr == 1) PG8_BAR;
    PG8_WAIT_V(2); PG8_BAR;
    PG8_STAGE(PG8_SB(1, 0), cB + kstep, voffB); PG8_STA_C(PG8_SA(1, 0), cA + kstep, 0); PG8_STAGE(PG8_SB(1, 1), cB + hsB + kstep, voffB);
    PG8_WAIT_V(6); PG8_BAR;
    for (;;) {
        const bool has_next = S.next(ui + 1, nxt);
        const char* nA = GATHER ? cA : (has_next ? PG8_ABASE(nxt) : cA); const char* nB = has_next ? PG8_BBASE(nxt) : cB;
        if constexpr (GATHER) { if (has_next) PG8_GOFF(ogn, nxt); }
#pragma clang loop unroll(disable)
        for (int t = 0; t < nt; t += 2) {
            const bool last = (t == nt - 2); const bool fresh = (t == 0) && (ui > 0);
            const char* a1 = cA + (size_t)(t + 1) * kstep;
            const char* a2 = last ? nA : cA + (size_t)(t + 2) * kstep; const char* b2 = last ? nB : cB + (size_t)(t + 2) * kstep;
            const char* a3 = a2 + kstep; const char* b3 = b2 + kstep;
            unsigned ogx[2][2];
            if constexpr (GATHER) { _Pragma("unroll") for (int _h = 0; _h < 2; ++_h) _Pragma("unroll") for (int _i = 0; _i < 2; ++_i) ogx[_h][_i] = last ? ogn[_h][_i] : ogc[_h][_i]; }
            PG8_LDB(B0, 0, 0); PG8_LDB(B1, 0, 1); PG8_SCHED; PG8_LDA(At, 0, 0); PG8_STA_C(PG8_SA(1, 1), a1, 1);
            PG8_WAIT_V8F(fresh); PG8_WAIT_L(0); PG8_BAR; PG8_MMA(0, 0, At, B0); PG8_MMA(0, 1, At, B1); PG8_BAR; PG8_SCHED;
            PG8_LDA(At, 0, 1); PG8_STAGE(PG8_SB(0, 0), b2, voffB); PG8_STAGE(PG8_SB(0, 1), b2 + hsB, voffB); PG8_STA_X(PG8_SA(0, 0), a2, 0);
            PG8_WAIT_V8F(fresh); PG8_WAIT_L(0); PG8_BAR; PG8_MMA(1, 0, At, B0); PG8_MMA(1, 1, At, B1); PG8_BAR; PG8_SCHED;
            PG8_LDB(B0, 1, 0); PG8_LDB(B1, 1, 1); PG8_SCHED; PG8_LDA(At, 1, 0); PG8_STA_X(PG8_SA(0, 1), a2, 1);
            PG8_WAIT_V(8); PG8_WAIT_L(0); PG8_BAR; PG8_MMA(0, 0, At, B0); PG8_MMA(0, 1, At, B1); PG8_BAR; PG8_SCHED;
            PG8_LDA(At, 1, 1); PG8_STAGE(PG8_SB(1, 0), b3, voffB); PG8_STAGE(PG8_SB(1, 1), b3 + hsB, voffB); PG8_STA_X(PG8_SA(1, 0), a3, 0);
            PG8_WAIT_V(8); PG8_WAIT_L(0); PG8_BAR; PG8_MMA(1, 0, At, B0); PG8_MMA(1, 1, At, B1); PG8_BAR; PG8_SCHED;
        }
        if (wr == 0) PG8_BAR;
        asm volatile("s_nop 15\n\ts_nop 15" ::: "memory");
        E(acc, cur, wr, wc, fr, fq);
        if (!has_next) break;
#pragma unroll
        for (int a = 0; a < 2; ++a)
#pragma unroll
            for (int b = 0; b < 2; ++b)
#pragma unroll
                for (int m = 0; m < 4; ++m)
#pragma unroll
                    for (int n = 0; n < 2; ++n) { acc[a][b][m][n] = (f32x4){0.f, 0.f, 0.f, 0.f}; asm volatile("" : "+v"(acc[a][b][m][n])); }
        cur = nxt; cA = nA; cB = nB; ++ui;
        if constexpr (GATHER) { _Pragma("unroll") for (int _h = 0; _h < 2; ++_h) _Pragma("unroll") for (int _i = 0; _i < 2; ++_i) ogc[_h][_i] = ogn[_h][_i]; }
        if (wr == 1) PG8_BAR;
    }
    PG8_WAIT_V(0);
    PG8_BAR;
#undef PG8_SA
#undef PG8_SB
#undef PG8_STAGE
#undef PG8_LDA
#undef PG8_LDB
#undef PG8_MMA
#undef PG8_WAIT_V
#undef PG8_WAIT_L
#undef PG8_WAIT_V8F
#undef PG8_BAR
#undef PG8_SCHED
#undef PG8_ABASE
#undef PG8_BBASE
#undef PG8_LD32
#undef PG8_GOFF
#undef PG8_STA_C
#undef PG8_STAGE_BUF
#undef PG8_STA_X
}

typedef const f32x4 (&AccRef)[2][2][4][2];

__device__ __forceinline__ u32x4 pack8(f32x4 v0, f32x4 v1) { u32x4 w; w.x = cvt_pk_bf16(v0[0], v0[1]); w.y = cvt_pk_bf16(v0[2], v0[3]); w.z = cvt_pk_bf16(v1[0], v1[1]); w.w = cvt_pk_bf16(v1[2], v1[3]); return w; }

struct EpiInProj {
    static constexpr bool PERM = true; static constexpr int NST = 16;
    bf16_t* Z; const float* ropec; const float* ropes;
    __device__ __forceinline__ void operator()(AccRef acc, const Unit& u, int wr, int wc, int fr, int fq) const {
        const int bt = u.pm / 33; const bool ctx = (u.pm - bt * 33) == 0; const bool rope = (u.pn < 4) && !ctx;
        const int row0 = u.pm * BM + wr * 64 + fr, col0 = u.pn * BM + wc * 32 + 8 * fq;
        const int tbase = row0 - bt * SP - CTXL;
#pragma unroll
        for (int ai = 0; ai < 2; ++ai)
#pragma unroll
            for (int m = 0; m < 4; ++m) {
                const int row = row0 + ai * HALF + m * 16; bf16_t* rowp = Z + (size_t)row * 2048 + col0;
                f32x4 c0 = {1.f, 1.f, 1.f, 1.f}, c1 = c0, s0 = {0.f, 0.f, 0.f, 0.f}, s1 = s0;
                if (rope) { const int t = tbase + ai * HALF + m * 16; const int pos = (wc & 1) ? (t & 63) : (t >> 6); const int o = pos * 16 + 8 * (fq & 1);
                    c0 = *(const f32x4*)(ropec + o); c1 = *(const f32x4*)(ropec + o + 4); s0 = *(const f32x4*)(ropes + o); s1 = *(const f32x4*)(ropes + o + 4);
                    if (fq < 2) { s0 = -s0; s1 = -s1; } }
#pragma unroll
                for (int bj = 0; bj < 2; ++bj) { f32x4 v0 = acc[ai][bj][m][0], v1 = acc[ai][bj][m][1];
                    if (rope) { f32x4 p0, p1;
#pragma unroll
                        for (int j = 0; j < 4; ++j) { p0[j] = __shfl_xor(v0[j], 32); p1[j] = __shfl_xor(v1[j], 32); }
                        v0 = v0 * c0 + p0 * s0; v1 = v1 * c1 + p1 * s1; }
                    *(u32x4*)(rowp + bj * HALF) = pack8(v0, v1); } }
    }
};
struct EpiResid {
    static constexpr bool PERM = false; static constexpr int NST = 32;
    const float* xin_lat; const float* xin_ctx; bf16_t* hb; const float* mod; int tokmode;
    __device__ __forceinline__ void operator()(AccRef acc, const Unit& u, int wr, int wc, int fr, int fq) const {
        const float* xin = nullptr; const float* gate; int rl0, rt0;
        if (tokmode) { const int bt = u.pm / 33, pt = u.pm - bt * 33; rt0 = u.pm * BM;
            if (pt == 0) { xin = xin_ctx; gate = mod + 4 * 6144 + 2048; rl0 = bt * CTXL; }
            else { xin = xin_lat; gate = mod + bt * 6144 + 2048; rl0 = bt * SEQ + (pt - 1) * BM; } }
        else { const int bt = u.pm / 32; gate = mod + bt * 6144 + 2048; rl0 = 0; rt0 = bt * SP + CTXL + (u.pm - bt * 32) * BM; }
        const int col0 = u.pn * BM + wc * 32 + 4 * fq;
        f32x4 gv[2][2];
#pragma unroll
        for (int bj = 0; bj < 2; ++bj)
#pragma unroll
            for (int n = 0; n < 2; ++n) gv[bj][n] = *(const f32x4*)(gate + col0 + bj * HALF + n * 16);
#pragma unroll
        for (int ai = 0; ai < 2; ++ai)
#pragma unroll
            for (int m = 0; m < 4; ++m) { const int rr = wr * 64 + fr + ai * HALF + m * 16; const size_t offx = (size_t)(rl0 + rr) * DM + col0; bf16_t* hp = hb + (size_t)(rt0 + rr) * DM + col0;
#pragma unroll
                for (int bj = 0; bj < 2; ++bj)
#pragma unroll
                    for (int n = 0; n < 2; ++n) { f32x4 hv;
                        if (tokmode) hv = *(const f32x4*)(xin + offx + bj * HALF + n * 16);
                        else { const u32x2 w = *(const u32x2*)(hp + bj * HALF + n * 16); hv = (f32x4){bflo(w.x), bfhi(w.x), bflo(w.y), bfhi(w.y)}; }
                        const f32x4 o = hv + gv[bj][n] * acc[ai][bj][m][n];
                        u32x2 wo; wo.x = cvt_pk_bf16(o.x, o.y); wo.y = cvt_pk_bf16(o.z, o.w); *(u32x2*)(hp + bj * HALF + n * 16) = wo; }
                asm volatile("" ::: "memory"); }
    }
};
struct EpiGateUp {
    static constexpr bool PERM = true; static constexpr int NST = 8;
    unsigned char* H; float sc;
    __device__ __forceinline__ void operator()(AccRef acc, const Unit& u, int wr, int wc, int fr, int fq) const {
        const int row0 = u.pm * BM + wr * 64 + fr, col0 = u.pn * HALF + wc * 32 + 8 * fq;
        unsigned char* base = H + (size_t)u.g * XROWS * EHID;
#pragma unroll
        for (int ai = 0; ai < 2; ++ai)
#pragma unroll
            for (int m = 0; m < 4; ++m) { f32x4 o0, o1;
#pragma unroll
                for (int j = 0; j < 4; ++j) { o0[j] = siluf_(acc[ai][0][m][0][j] * sc) * (acc[ai][1][m][0][j] * sc); o1[j] = siluf_(acc[ai][0][m][1][j] * sc) * (acc[ai][1][m][1][j] * sc); }
                u32x2 w; w.x = pk4_fp8(o0[0], o0[1], o0[2], o0[3]); w.y = pk4_fp8(o1[0], o1[1], o1[2], o1[3]);
                *(u32x2*)(base + (size_t)(row0 + ai * HALF + m * 16) * EHID + col0) = w; }
    }
};
struct EpiBf16 {
    static constexpr bool PERM = true; static constexpr int NST = 16;
    bf16_t* O; int ldc; size_t gsO; float sc;
    __device__ __forceinline__ void operator()(AccRef acc, const Unit& u, int wr, int wc, int fr, int fq) const {
        const int row0 = u.pm * BM + wr * 64 + fr, col0 = u.pn * BM + wc * 32 + 8 * fq;
        bf16_t* base = O + (size_t)u.g * gsO;
#pragma unroll
        for (int ai = 0; ai < 2; ++ai)
#pragma unroll
            for (int m = 0; m < 4; ++m) { bf16_t* rowp = base + (size_t)(row0 + ai * HALF + m * 16) * ldc + col0;
#pragma unroll
                for (int bj = 0; bj < 2; ++bj) *(u32x4*)(rowp + bj * HALF) = pack8(acc[ai][bj][m][0] * sc, acc[ai][bj][m][1] * sc); }
    }
};
constexpr float YS_SCALE = 16.f;
struct EpiF8Out {
    static constexpr bool PERM = true; static constexpr int NST = 16;
    unsigned char* O; int ldc; size_t gsO;
    __device__ __forceinline__ void operator()(AccRef acc, const Unit& u, int wr, int wc, int fr, int fq) const {
        const int row0 = u.pm * BM + wr * 64 + fr, col0 = u.pn * BM + wc * 32 + 8 * fq;
        unsigned char* base = O + (size_t)u.g * gsO;
#pragma unroll
        for (int ai = 0; ai < 2; ++ai)
#pragma unroll
            for (int m = 0; m < 4; ++m) { unsigned char* rowp = base + (size_t)(row0 + ai * HALF + m * 16) * ldc + col0;
#pragma unroll
                for (int bj = 0; bj < 2; ++bj) { const f32x4 a0 = acc[ai][bj][m][0] * YS_SCALE, a1 = acc[ai][bj][m][1] * YS_SCALE;
                    u32x2 w; w.x = pk4_fp8(a0[0], a0[1], a0[2], a0[3]); w.y = pk4_fp8(a1[0], a1[1], a1[2], a1[3]); *(u32x2*)(rowp + bj * HALF) = w; } }
    }
};
struct EpiF32 {
    static constexpr bool PERM = false; static constexpr int NST = 32;
    float* C; int ldc; size_t gsC;
    __device__ __forceinline__ void operator()(AccRef acc, const Unit& u, int wr, int wc, int fr, int fq) const {
        const int row0 = u.pm * BM + wr * 64 + fr, col0 = u.pn * BM + wc * 32 + 4 * fq;
        float* base = C + (size_t)u.g * gsC;
#pragma unroll
        for (int ai = 0; ai < 2; ++ai)
#pragma unroll
            for (int m = 0; m < 4; ++m) { float* rowp = base + (size_t)(row0 + ai * HALF + m * 16) * ldc + col0;
#pragma unroll
                for (int bj = 0; bj < 2; ++bj)
#pragma unroll
                    for (int n = 0; n < 2; ++n) *(f32x4*)(rowp + bj * HALF + n * 16) = acc[ai][bj][m][n]; }
    }
};
struct EpiSsmIn {
    static constexpr bool PERM = true; static constexpr int NST = 16;
    bf16_t* U;
    __device__ __forceinline__ void operator()(AccRef acc, const Unit& u, int wr, int wc, int fr, int fq) const {
        const int bt = u.pm / 33, pt = u.pm - bt * 33;
        const int rin0 = wr * 64 + fr;
        const int urow_base = (pt == 0) ? (1024 + bt * NCHC) : (bt * NCHL + (pt - 1) * (BM / SL));
        const int gb = 16 * u.pn + 2 * wc + (fq >> 1), ch0 = 8 * (fq & 1);
#pragma unroll
        for (int ai = 0; ai < 2; ++ai)
#pragma unroll
            for (int m = 0; m < 4; ++m) { const int rin = rin0 + ai * HALF + m * 16; const int urow = urow_base + (rin >> 5), tl = rin & 31;
#pragma unroll
                for (int bj = 0; bj < 2; ++bj) { const int g = gb + 8 * bj;
                    *(u32x4*)(U + ((size_t)g * UROWS + urow) * UK + tl * 16 + ch0) = pack8(acc[ai][bj][m][0], acc[ai][bj][m][1]); } }
    }
};
struct EpiSsmY {
    static constexpr bool PERM = true; static constexpr int NST = 16;
    bf16_t* ZG;
    __device__ __forceinline__ void operator()(AccRef acc, const Unit& u, int wr, int wc, int fr, int fq) const {
        const int row0 = u.pm * BM + wr * 64 + fr;
        const int tl0 = 16 * u.pn + 2 * wc + (fq >> 1), ch0 = 8 * (fq & 1);
#pragma unroll
        for (int ai = 0; ai < 2; ++ai)
#pragma unroll
            for (int m = 0; m < 4; ++m) { const int crow = row0 + ai * HALF + m * 16;
#pragma unroll
                for (int bj = 0; bj < 2; ++bj) { const int tl = tl0 + 8 * bj; f32x4 o0, o1;
#pragma unroll
                    for (int j = 0; j < 4; ++j) { o0[j] = gelu_tanh_(acc[ai][bj][m][0][j]); o1[j] = gelu_tanh_(acc[ai][bj][m][1][j]); }
                    *(u32x4*)(ZG + ((size_t)crow * SL + tl) * DM + u.g * 16 + ch0) = pack8(o0, o1); } }
    }
};
struct EpiGlu {
    static constexpr bool PERM = true; static constexpr int NST = 16;
    const bf16_t* ZG; bf16_t* ZZ;
    __device__ __forceinline__ void operator()(AccRef acc, const Unit& u, int wr, int wc, int fr, int fq) const {
        const int row0 = u.pm * BM + wr * 64 + fr, col0 = u.pn * BM + wc * 32 + 8 * fq;
#pragma unroll
        for (int ai = 0; ai < 2; ++ai)
#pragma unroll
            for (int m = 0; m < 4; ++m) { const size_t off = (size_t)(row0 + ai * HALF + m * 16) * DM + col0;
#pragma unroll
                for (int bj = 0; bj < 2; ++bj) { const u32x4 z = *(const u32x4*)(ZG + off + bj * HALF); const f32x4 a0 = acc[ai][bj][m][0], a1 = acc[ai][bj][m][1]; f32x4 o0, o1;
                    o0[0] = bflo(z.x) * sigmoidf_(a0[0]); o0[1] = bfhi(z.x) * sigmoidf_(a0[1]); o0[2] = bflo(z.y) * sigmoidf_(a0[2]); o0[3] = bfhi(z.y) * sigmoidf_(a0[3]);
                    o1[0] = bflo(z.z) * sigmoidf_(a1[0]); o1[1] = bfhi(z.z) * sigmoidf_(a1[1]); o1[2] = bflo(z.w) * sigmoidf_(a1[2]); o1[3] = bfhi(z.w) * sigmoidf_(a1[3]);
                    u32x2 w8; w8.x = pk4_fp8(o0[0], o0[1], o0[2], o0[3]); w8.y = pk4_fp8(o1[0], o1[1], o1[2], o1[3]);
                    *(u32x2*)((unsigned char*)ZZ + off + bj * HALF) = w8; } }
    }
};
}
namespace dattn {
constexpr int KVBLK = 64, LDZ = 2048;
constexpr float SCALE = 0.125f, THR = 8.f;
constexpr int SHM_V = KVBLK * 128 * 2, SHM_K = KVBLK * 128 * 2, SHM_ATTN = 2 * SHM_V + 2 * SHM_K + 8 * 64 * 4;
#define KSWZ(row, colB) ((row) * 256 + ((colB) ^ (((row) & 7) << 4)))
#define SBAR() __builtin_amdgcn_sched_barrier(0)
__device__ __forceinline__ int crow(int r, int hi) { return (r & 3) + 8 * (r >> 2) + 4 * hi; }
__device__ __forceinline__ float vadd(float a, float b) { float r = a + b; asm("" : "+v"(r)); return r; }
__device__ __forceinline__ void partialSM(f32x16& p0, f32x16& p1, float& m_reg, float& mn, float& alpha) {
  constexpr float C = SCALE * 1.4426950408889634f;
  float c0 = fmaxf(fmaxf(p0[0], p0[1]), p0[2]), c1 = fmaxf(fmaxf(p0[8], p0[9]), p0[10]), c2 = fmaxf(fmaxf(p1[0], p1[1]), p1[2]), c3 = fmaxf(fmaxf(p1[8], p1[9]), p1[10]);
  c0 = fmaxf(fmaxf(c0, p0[3]), p0[4]); c1 = fmaxf(fmaxf(c1, p0[11]), p0[12]); c2 = fmaxf(fmaxf(c2, p1[3]), p1[4]); c3 = fmaxf(fmaxf(c3, p1[11]), p1[12]);
  c0 = fmaxf(fmaxf(c0, p0[5]), p0[6]); c1 = fmaxf(fmaxf(c1, p0[13]), p0[14]); c2 = fmaxf(fmaxf(c2, p1[5]), p1[6]); c3 = fmaxf(fmaxf(c3, p1[13]), p1[14]);
  c0 = fmaxf(fmaxf(c0, p0[7]), c1); c2 = fmaxf(fmaxf(c2, p1[7]), c3); c0 = fmaxf(fmaxf(c0, p0[15]), p1[15]);
  float pmax = fmaxf(c0, c2);
  { auto rr = __builtin_amdgcn_permlane32_swap(__float_as_uint(pmax), __float_as_uint(pmax), false, false);
    pmax = fmaxf(__uint_as_float(rr[0]), __uint_as_float(rr[1])); }
  if (__builtin_expect(__all(pmax - m_reg <= THR / SCALE), 1)) { mn = m_reg; alpha = 1.f; }
  else { mn = fmaxf(m_reg, pmax); alpha = __builtin_amdgcn_exp2f((m_reg - mn) * C); m_reg = mn; }
  float mnC = -mn * C;
#pragma unroll
  for (int r = 0; r < 16; ++r) p0[r] = fmaf(p0[r], C, mnC);
#pragma unroll
  for (int r = 0; r < 16; ++r) p1[r] = fmaf(p1[r], C, mnC);
#pragma unroll
  for (int r = 0; r < 16; ++r) p0[r] = __builtin_amdgcn_exp2f(p0[r]);
}
__device__ __forceinline__ void finishSM(f32x16& p0, f32x16& p1, float alpha, float& l_reg, bf16x8& pa0, bf16x8& pa1, bf16x8& pa2, bf16x8& pa3) {
#pragma unroll
  for (int r = 0; r < 16; ++r) p1[r] = __builtin_amdgcn_exp2f(p1[r]);
  float s0 = vadd(p0[0], p0[1]), s1 = vadd(p0[8], p0[9]), s2 = vadd(p1[0], p1[1]), s3 = vadd(p1[8], p1[9]);
#pragma unroll
  for (int r = 2; r < 8; ++r) { s0 = vadd(s0, p0[r]); s1 = vadd(s1, p0[8 + r]); s2 = vadd(s2, p1[r]); s3 = vadd(s3, p1[8 + r]); }
  float ps = vadd(vadd(s0, s1), vadd(s2, s3));
  { auto rr = __builtin_amdgcn_permlane32_swap(__float_as_uint(ps), __float_as_uint(ps), false, false);
    ps = __uint_as_float(rr[0]) + __uint_as_float(rr[1]); }
  l_reg = l_reg * alpha + ps;
#define PK4(P, BASE, OUT) do { unsigned a0 = cvt_pk_bf16(P[BASE + 0], P[BASE + 1]), a1 = cvt_pk_bf16(P[BASE + 2], P[BASE + 3]);   \
    unsigned b0 = cvt_pk_bf16(P[BASE + 4], P[BASE + 5]), b1 = cvt_pk_bf16(P[BASE + 6], P[BASE + 7]);                              \
    auto r0 = __builtin_amdgcn_permlane32_swap(a0, b0, false, false); auto r1 = __builtin_amdgcn_permlane32_swap(a1, b1, false, false); \
    u32x4 w = {r0[0], r1[0], r0[1], r1[1]}; OUT = *reinterpret_cast<bf16x8*>(&w); } while (0)
  PK4(p0, 0, pa0); PK4(p0, 8, pa1); PK4(p1, 0, pa2); PK4(p1, 8, pa3);
#undef PK4
}
__device__ __forceinline__ void qkt(f32x16& p0, f32x16& p1, const char* Ks, const bf16x8* qr, int r32, int hi, int cmapB) {
  p0 = f32x16{}; p1 = f32x16{};
#pragma unroll
  for (int d0 = 0; d0 < 4; ++d0) { int cb = cmapB + (d0 * 16 + hi * 8) * 2;
    bf16x8 b0 = *reinterpret_cast<const bf16x8*>(Ks + KSWZ(r32, cb));
    bf16x8 b1 = *reinterpret_cast<const bf16x8*>(Ks + KSWZ(32 + r32, cb));
    p0 = __builtin_amdgcn_mfma_f32_32x32x16_bf16(b0, qr[d0], p0, 0, 0, 0);
    p1 = __builtin_amdgcn_mfma_f32_32x32x16_bf16(b1, qr[d0], p1, 0, 0, 0); }
}
__device__ __forceinline__ int v_st(int k, int c) { const int kk = (k & ~0xC) | ((k & 4) << 1) | ((k & 8) >> 1); return ((kk >> 3) * 4 + (c >> 5)) * 512 + ((kk & 7) * 32 + (c & 31)) * 2; }
__device__ __forceinline__ int v_rd_base(int lane) { return ((lane & 3) << 3) | (((lane >> 2) & 3) << 6) | (((lane >> 4) & 1) << 5) | (((lane >> 5) & 1) << 8); }
constexpr int v_rd_off(int d0, int ks, int half) { return d0 * 512 + ks * 4096 + half * 2048; }
typedef s16x4 LAS* lds_s16x4_ptr;
template <int OFF> __device__ __forceinline__ s16x4 tr_read(const LAS char* vb) {
  return __builtin_amdgcn_ds_read_tr16_b64_v4i16((lds_s16x4_ptr)(vb + OFF));
}
template <int D0> __device__ __forceinline__ void pv_one(f32x16& od, const LAS char* vb, bf16x8 pa0, bf16x8 pa1, bf16x8 pa2, bf16x8 pa3) {
  const s16x4 l0 = tr_read<v_rd_off(D0, 0, 0)>(vb), h0 = tr_read<v_rd_off(D0, 0, 1)>(vb), l1 = tr_read<v_rd_off(D0, 1, 0)>(vb), h1 = tr_read<v_rd_off(D0, 1, 1)>(vb);
  const s16x4 l2 = tr_read<v_rd_off(D0, 2, 0)>(vb), h2 = tr_read<v_rd_off(D0, 2, 1)>(vb), l3 = tr_read<v_rd_off(D0, 3, 0)>(vb), h3 = tr_read<v_rd_off(D0, 3, 1)>(vb);
#define PK(L, H) (bf16x8){L[0], L[1], L[2], L[3], H[0], H[1], H[2], H[3]}
  od = __builtin_amdgcn_mfma_f32_32x32x16_bf16(pa0, PK(l0, h0), od, 0, 0, 0);
  od = __builtin_amdgcn_mfma_f32_32x32x16_bf16(pa1, PK(l1, h1), od, 0, 0, 0);
  od = __builtin_amdgcn_mfma_f32_32x32x16_bf16(pa2, PK(l2, h2), od, 0, 0, 0);
  od = __builtin_amdgcn_mfma_f32_32x32x16_bf16(pa3, PK(l3, h3), od, 0, 0, 0);
#undef PK
}
__device__ __forceinline__ void pv_d0(f32x16* o, const LAS char* vb, bf16x8 pa0, bf16x8 pa1, bf16x8 pa2, bf16x8 pa3) {
  pv_one<0>(o[0], vb, pa0, pa1, pa2, pa3); pv_one<1>(o[1], vb, pa0, pa1, pa2, pa3); pv_one<2>(o[2], vb, pa0, pa1, pa2, pa3); pv_one<3>(o[3], vb, pa0, pa1, pa2, pa3);
}
__device__ __forceinline__ void diff_attn_unit(const bf16_t* __restrict__ Zb, int qrow0, int h, int nkeys, bf16_t* __restrict__ Y1b, float lam, const float* __restrict__ subg, char* lds) {
  const int tid = threadIdx.x, wid = tid >> 6, lane = tid & 63, r32 = lane & 31, hi = lane >> 5;
  const int map = wid >> 2, qw = wid & 3;
  char* V_lds = lds; char* K_lds = lds + 2 * SHM_V;
  float* wsl = (float*)(lds + 2 * SHM_V + 2 * SHM_K) + wid * 64; float* li_l = wsl; float* al_l = wsl + 32;
  float m_reg = -1e30f, l_reg = 0; f32x16 o[4] = {}; bf16x8 qr[4];
  const bf16_t* Qw = Zb + (size_t)(qrow0 + qw * 32 + r32) * LDZ + h * 128 + map * 64 + hi * 8;
#pragma unroll
  for (int d0 = 0; d0 < 4; ++d0) qr[d0] = *reinterpret_cast<const bf16x8*>(Qw + d0 * 16);
  const bf16_t* Kh = Zb + 512 + h * 128; const bf16_t* Vh = Zb + 1024 + h * 128;
  const int sr = tid >> 4, sc = (tid & 15) * 8, vst0 = v_st(sr, sc), kst0 = KSWZ(sr, sc * 2);
  const LAS char* vb0 = (const LAS char*)V_lds + v_rd_base(lane);
  const int cmapB = map * 128;
  struct { bf16x8 vs0, vs1, ks0, ks1; } sr_[1];
#define SLOAD(i, k0) do { sr_[i].vs0 = *reinterpret_cast<const bf16x8*>(&Vh[(size_t)((k0) + sr) * LDZ + sc]); sr_[i].vs1 = *reinterpret_cast<const bf16x8*>(&Vh[(size_t)((k0) + 32 + sr) * LDZ + sc]); \
    sr_[i].ks0 = *reinterpret_cast<const bf16x8*>(&Kh[(size_t)((k0) + sr) * LDZ + sc]); sr_[i].ks1 = *reinterpret_cast<const bf16x8*>(&Kh[(size_t)((k0) + 32 + sr) * LDZ + sc]); } while (0)
#define SWRITE(b, i) do { *(bf16x8*)(V_lds + (b) * SHM_V + vst0) = sr_[i].vs0;          \
    *(bf16x8*)(V_lds + (b) * SHM_V + vst0 + 8192) = sr_[i].vs1;               \
    *(bf16x8*)(K_lds + (b) * SHM_K + kst0) = sr_[i].ks0;                       \
    *(bf16x8*)(K_lds + (b) * SHM_K + kst0 + 8192) = sr_[i].ks1; } while (0)
#define SWAIT() asm volatile("s_waitcnt vmcnt(0)" ::: "memory")
#define RESC(a) do { if (__any((a) < 1.f)) { if (hi == 0) al_l[r32] = (a); asm volatile("s_waitcnt lgkmcnt(0)" ::: "memory"); \
    _Pragma("unroll") for (int d = 0; d < 4; ++d) _Pragma("unroll") for (int r = 0; r < 16; ++r) o[d][r] *= al_l[crow(r, hi)]; } } while (0)
  f32x16 pA0, pA1, pB0, pB1; float mnA, mnB, alA, alB; bf16x8 pa0, pa1, pa2, pa3; const int NT = nkeys / KVBLK;
  constexpr int SE = 0, SO = 0;
  SLOAD(SE, 0); asm volatile("s_waitcnt vmcnt(0)" ::: "memory"); SWRITE(0, SE); __syncthreads();
  qkt(pA0, pA1, K_lds, qr, r32, hi, cmapB); partialSM(pA0, pA1, m_reg, mnA, alA);
  SLOAD(SO, KVBLK);
  SWAIT(); SWRITE(1, SO); __syncthreads();
  for (int j = 1; j + 1 < NT; j += 2) {
    SBAR(); qkt(pB0, pB1, K_lds + SHM_K, qr, r32, hi, cmapB);
    finishSM(pA0, pA1, alA, l_reg, pa0, pa1, pa2, pa3); SBAR();
    SLOAD(SO, (j + 1) * KVBLK); SBAR();
    pv_d0(o, vb0, pa0, pa1, pa2, pa3); partialSM(pB0, pB1, m_reg, mnB, alB);
    __syncthreads(); SWAIT(); SWRITE(0, SE);
    RESC(alB); __syncthreads();
    SBAR(); qkt(pA0, pA1, K_lds, qr, r32, hi, cmapB);
    finishSM(pB0, pB1, alB, l_reg, pa0, pa1, pa2, pa3); SBAR();
    SLOAD(SE, (j + 2) * KVBLK); SBAR();
    pv_d0(o, vb0 + SHM_V, pa0, pa1, pa2, pa3); partialSM(pA0, pA1, m_reg, mnA, alA);
    __syncthreads(); SWAIT(); SWRITE(1, SO);
    RESC(alA); __syncthreads();
  }
  SBAR(); qkt(pB0, pB1, K_lds + SHM_K, qr, r32, hi, cmapB);
  finishSM(pA0, pA1, alA, l_reg, pa0, pa1, pa2, pa3); SBAR();
  pv_d0(o, vb0, pa0, pa1, pa2, pa3); partialSM(pB0, pB1, m_reg, mnB, alB);
  __syncthreads(); RESC(alB);
  finishSM(pB0, pB1, alB, l_reg, pa0, pa1, pa2, pa3); SBAR();
  pv_d0(o, vb0 + SHM_V, pa0, pa1, pa2, pa3);
  if (hi == 0) li_l[r32] = l_reg; asm volatile("s_waitcnt lgkmcnt(0)" ::: "memory");
  float rli[16];
#pragma unroll
  for (int r = 0; r < 16; ++r) rli[r] = __builtin_amdgcn_rcpf(li_l[crow(r, hi)]);
  __syncthreads();
  float* X = (float*)lds + qw * (32 * 128);
  if (map == 1) {
#pragma unroll
    for (int d0 = 0; d0 < 4; ++d0)
#pragma unroll
      for (int r = 0; r < 16; ++r) X[crow(r, hi) * 128 + d0 * 32 + r32] = o[d0][r] * rli[r] * lam;
  }
  __syncthreads();
  if (map == 0) {
    float ss[16];
#pragma unroll
    for (int r = 0; r < 16; ++r) ss[r] = 0.f;
#pragma unroll
    for (int d0 = 0; d0 < 4; ++d0)
#pragma unroll
      for (int r = 0; r < 16; ++r) { const float v = o[d0][r] * rli[r] - X[crow(r, hi) * 128 + d0 * 32 + r32]; o[d0][r] = v; ss[r] += v * v; }
#pragma unroll
    for (int r = 0; r < 16; ++r) {
      ss[r] = half32_sum(ss[r]);
      ss[r] = 0.8f * __builtin_amdgcn_rsqf(ss[r] * (1.0f / 128.0f) + EPSN); }
    int r32e = r32; asm volatile("" : "+v"(r32e));
    float gv[4];
#pragma unroll
    for (int d0 = 0; d0 < 4; ++d0) gv[d0] = subg[d0 * 32 + r32e];
    bf16_t* Ow = Y1b + (size_t)(qrow0 + qw * 32) * DM + h * 128 + r32e;
#pragma unroll
    for (int r = 0; r < 16; ++r) { const int orow = crow(r, hi);
#pragma unroll
      for (int d0 = 0; d0 < 4; ++d0) { const unsigned w = cvt_pk_bf16(o[d0][r] * ss[r] * gv[d0], 0.f); Ow[(size_t)orow * DM + d0 * 32] = (bf16_t)(w & 0xffffu); } }
  }
  __syncthreads();
#undef SLOAD
#undef SWRITE
#undef SWAIT
#undef RESC
}


struct CvtState { int next, cur, np, tick; };
struct CvtCtx { const float* wg; const float* wu; const float* wd; unsigned char* GU; unsigned char* DN; int gw, ngw, nitems; };
__device__ __forceinline__ void cvt_decode(const CvtCtx& C, int r, const float*& src, int& ldw, unsigned char*& dst, int& ldd) {
  const int le = r / 3072, q3 = r - le * 3072, which = q3 >> 10, q = q3 & 1023;
  if (which < 2) { const int kb = q >> 6, nb = q & 63, n0 = nb * 32; src = (which == 0 ? C.wg : C.wu) + (size_t)le * 1024 * 2048 + (size_t)(kb * 64) * 2048 + n0; ldw = 2048;
    dst = C.GU + (size_t)le * 4096 * 1024 + (size_t)((n0 >> 7) * 256 + which * 128 + (n0 & 127)) * 1024 + kb * 64; ldd = 1024; }
  else { const int kb = q >> 5, nb = q & 31; src = C.wd + (size_t)le * 2048 * 1024 + (size_t)(kb * 64) * 1024 + nb * 32; ldw = 1024;
    dst = C.DN + (size_t)le * 1024 * 2048 + (size_t)(nb * 32) * 2048 + kb * 64; ldd = 2048; }
}
__device__ __forceinline__ void cvt_issue(const CvtCtx& C, int r, LAS char* scr, int lane, int j0, int j1) {
  const float* src; int ldw; unsigned char* dst; int ldd; cvt_decode(C, r, src, ldw, dst, ldd);
  const __amdgpu_buffer_rsrc_t rs = __builtin_amdgcn_make_buffer_rsrc((void*)src, 0, 64 * 2048 * 4, 0x00020000);
  const int vo = ((lane >> 3) * ldw + (lane & 7) * 4) * 4;
  for (int j = j0; j < j1; ++j) __builtin_amdgcn_raw_ptr_buffer_load_lds(rs, (LAS void*)(scr + j * 1024), 16, vo, j * 8 * ldw * 4, 0, 2);
}
__device__ __forceinline__ void cvt_finish(const CvtCtx& C, int r, const LAS char* scr, int lane) {
  const float* src; int ldw; unsigned char* dst; int ldd; cvt_decode(C, r, src, ldw, dst, ldd);
  const int kq = lane >> 3, ng = lane & 7; const LAS float* s = (const LAS float*)scr + (8 * kq) * 32 + ng * 4;
  f32x4 v[8];
#pragma unroll
  for (int i = 0; i < 8; ++i) { v[i] = *(const LAS f32x4*)(s + i * 32); v[i] *= 32.f; }
  unsigned char* d = dst + (size_t)(4 * ng) * ldd + 8 * kq;
#pragma unroll
  for (int j = 0; j < 4; ++j) { u32x2 o; o.x = pk4_fp8(v[0][j], v[1][j], v[2][j], v[3][j]); o.y = pk4_fp8(v[4][j], v[5][j], v[6][j], v[7][j]); *(u32x2*)(d + (size_t)j * ldd) = o; }
}
__device__ __forceinline__ void cvt_wave_step(const CvtCtx& C, CvtState& S, LAS char* scr, int lane, int ph) {
  if (ph == 0) { if (S.cur < 0) { const int r = C.gw + S.next * C.ngw; if (r < C.nitems) { S.cur = r; S.np = 8; ++S.next; cvt_issue(C, r, scr, lane, 0, 8); } } }
  else if (ph == 3) { if (S.cur >= 0) { asm volatile("s_waitcnt vmcnt(0)" ::: "memory"); cvt_finish(C, S.cur, scr, lane); S.cur = -1; asm volatile("s_waitcnt lgkmcnt(0)" ::: "memory"); } }
}
__device__ __forceinline__ void cvt_drain(const CvtCtx& C, CvtState& S, LAS char* scr, int lane) {
  asm volatile("s_waitcnt vmcnt(0)" ::: "memory");
  for (;;) {
    if (S.cur >= 0) { if (S.np < 8) { cvt_issue(C, S.cur, scr, lane, S.np, 8); S.np = 8; asm volatile("s_waitcnt vmcnt(0)" ::: "memory"); }
      cvt_finish(C, S.cur, scr, lane); S.cur = -1; asm volatile("s_waitcnt lgkmcnt(0)" ::: "memory"); }
    const int r = C.gw + S.next * C.ngw; if (r >= C.nitems) break;
    S.cur = r; S.np = 0; ++S.next;
  }
}
__device__ __forceinline__ void softmax_full(f32x16& p0, f32x16& p1, float& m_reg, float& l_reg, float& alpha, bf16x8& pa0, bf16x8& pa1, bf16x8& pa2, bf16x8& pa3) {
  constexpr float C = SCALE * 1.4426950408889634f;
  float c0 = fmaxf(fmaxf(p0[0], p0[1]), p0[2]), c1 = fmaxf(fmaxf(p0[8], p0[9]), p0[10]), c2 = fmaxf(fmaxf(p1[0], p1[1]), p1[2]), c3 = fmaxf(fmaxf(p1[8], p1[9]), p1[10]);
  c0 = fmaxf(fmaxf(c0, p0[3]), p0[4]); c1 = fmaxf(fmaxf(c1, p0[11]), p0[12]); c2 = fmaxf(fmaxf(c2, p1[3]), p1[4]); c3 = fmaxf(fmaxf(c3, p1[11]), p1[12]);
  c0 = fmaxf(fmaxf(c0, p0[5]), p0[6]); c1 = fmaxf(fmaxf(c1, p0[13]), p0[14]); c2 = fmaxf(fmaxf(c2, p1[5]), p1[6]); c3 = fmaxf(fmaxf(c3, p1[13]), p1[14]);
  c0 = fmaxf(fmaxf(c0, p0[7]), c1); c2 = fmaxf(fmaxf(c2, p1[7]), c3); c0 = fmaxf(fmaxf(c0, p0[15]), p1[15]);
  float pmax = fmaxf(c0, c2);
  { auto rr = __builtin_amdgcn_permlane32_swap(__float_as_uint(pmax), __float_as_uint(pmax), false, false);
    pmax = fmaxf(__uint_as_float(rr[0]), __uint_as_float(rr[1])); }
  float mn;
  if (__builtin_expect(__all(pmax - m_reg <= THR / SCALE), 1)) { mn = m_reg; alpha = 1.f; }
  else { mn = fmaxf(m_reg, pmax); alpha = __builtin_amdgcn_exp2f((m_reg - mn) * C); m_reg = mn; }
  const float mnC = -mn * C;
#pragma unroll
  for (int r = 0; r < 16; ++r) p0[r] = __builtin_amdgcn_exp2f(fmaf(p0[r], C, mnC));
#pragma unroll
  for (int r = 0; r < 16; ++r) p1[r] = __builtin_amdgcn_exp2f(fmaf(p1[r], C, mnC));
  float s0 = vadd(p0[0], p0[1]), s1 = vadd(p0[8], p0[9]), s2 = vadd(p1[0], p1[1]), s3 = vadd(p1[8], p1[9]);
#pragma unroll
  for (int r = 2; r < 8; ++r) { s0 = vadd(s0, p0[r]); s1 = vadd(s1, p0[8 + r]); s2 = vadd(s2, p1[r]); s3 = vadd(s3, p1[8 + r]); }
  float ps = vadd(vadd(s0, s1), vadd(s2, s3));
  { auto rr = __builtin_amdgcn_permlane32_swap(__float_as_uint(ps), __float_as_uint(ps), false, false);
    ps = __uint_as_float(rr[0]) + __uint_as_float(rr[1]); }
  l_reg = l_reg * alpha + ps;
#define PK4(P, BASE, OUT) do { unsigned a0 = cvt_pk_bf16(P[BASE + 0], P[BASE + 1]), a1 = cvt_pk_bf16(P[BASE + 2], P[BASE + 3]);   \
    unsigned b0 = cvt_pk_bf16(P[BASE + 4], P[BASE + 5]), b1 = cvt_pk_bf16(P[BASE + 6], P[BASE + 7]);                              \
    auto r0 = __builtin_amdgcn_permlane32_swap(a0, b0, false, false); auto r1 = __builtin_amdgcn_permlane32_swap(a1, b1, false, false); \
    u32x4 w = {r0[0], r1[0], r0[1], r1[1]}; OUT = *reinterpret_cast<bf16x8*>(&w); } while (0)
  PK4(p0, 0, pa0); PK4(p0, 8, pa1); PK4(p1, 0, pa2); PK4(p1, 8, pa3);
#undef PK4
}
__device__ __forceinline__ void diff_attn_unit_p3(const bf16_t* __restrict__ Zb, int qrow0, int h, int nkeys, bf16_t* __restrict__ Y1b, float lam, const float* __restrict__ subg, char* lds, const CvtCtx& CC, CvtState& CS) {
  const int tid = threadIdx.x, wid = __builtin_amdgcn_readfirstlane(tid >> 6), lane = tid & 63, r32 = lane & 31, hi = lane >> 5;
  const int map = wid >> 2, qw = wid & 3;
  char* V_lds = lds; char* K_lds = lds + 2 * SHM_V;
  float* wsl = (float*)(lds + 2 * SHM_V + 2 * SHM_K) + wid * 64; float* li_l = wsl; float* al_l = wsl + 32;
  float m_reg = -1e30f, l_reg = 0; f32x16 o[4] = {}; bf16x8 qr[4];
  const bf16_t* Qw = Zb + (size_t)(qrow0 + qw * 32 + r32) * LDZ + h * 128 + map * 64 + hi * 8;
#pragma unroll
  for (int d0 = 0; d0 < 4; ++d0) qr[d0] = *reinterpret_cast<const bf16x8*>(Qw + d0 * 16);
  const LAS char* vb0 = (const LAS char*)V_lds + v_rd_base(lane);
  const int cmapB = map * 128;
  const __amdgpu_buffer_rsrc_t rsZ = __builtin_amdgcn_make_buffer_rsrc((void*)Zb, 0, SP * LDZ * 2, 0x00020000);
  int dofV[4], dofK[4];
#pragma unroll
  for (int q = 0; q < 4; ++q) { const int sp = (wid & 3) * 4 + q;
    { const int stl = 2 * sp + (lane >> 5), kk = (stl >> 2) * 8 + ((lane & 31) >> 2), k = (kk & ~0xC) | ((kk & 4) << 1) | ((kk & 8) >> 1), c = (stl & 3) * 32 + (lane & 3) * 8;
      dofV[q] = (k * LDZ + 1024 + h * 128 + c) * 2; }
    { const int r = 4 * sp + (lane >> 4), ch = (lane & 15) ^ (r & 7);
      dofK[q] = (r * LDZ + 512 + h * 128 + ch * 8) * 2; } }
#define DMA_KV(tk, bk, tv, bv) do { if (wid < 4) { const int soV_ = (tv) * (KVBLK * LDZ * 2), soK_ = (tk) * (KVBLK * LDZ * 2); \
    LAS char* lv_ = (LAS char*)lds + (bv) * SHM_V + (wid & 3) * 4096; LAS char* lk_ = (LAS char*)lds + 2 * SHM_V + (bk) * SHM_K + (wid & 3) * 4096; \
    _Pragma("unroll") for (int q = 0; q < 4; ++q) __builtin_amdgcn_raw_ptr_buffer_load_lds(rsZ, (LAS void*)(lv_ + q * 1024), 16, dofV[q], soV_, 0, 0); \
    _Pragma("unroll") for (int q = 0; q < 4; ++q) __builtin_amdgcn_raw_ptr_buffer_load_lds(rsZ, (LAS void*)(lk_ + q * 1024), 16, dofK[q], soK_, 0, 0); } } while (0)
#define TSYNC() do { asm volatile("s_waitcnt vmcnt(0)" ::: "memory"); __syncthreads(); } while (0)
#define RESC(a) do { if (__any((a) < 1.f)) { if (hi == 0) al_l[r32] = (a); asm volatile("s_waitcnt lgkmcnt(0)" ::: "memory"); \
    _Pragma("unroll") for (int d = 0; d < 4; ++d) _Pragma("unroll") for (int r = 0; r < 16; ++r) o[d][r] *= al_l[crow(r, hi)]; } } while (0)
  const int NT = nkeys / KVBLK;
  f32x16 pA0, pA1, pB0, pB1; bf16x8 aA0, aA1, aA2, aA3, aB0, aB1, aB2, aB3; float alpha;
  DMA_KV(0, 0, 0, 0); DMA_KV(1, 1, 0, 0); TSYNC();
  qkt(pA0, pA1, K_lds, qr, r32, hi, cmapB);
  __syncthreads();
#define HALF(T, PC0, PC1, PN0, PN1, AC0, AC1, AC2, AC3, AP0, AP1, AP2, AP3, DOPV) do { \
    const int ph_ = (CS.tick++) & 3; \
    if (wid >= 4) cvt_wave_step(CC, CS, (LAS char*)lds + 67584 + (wid - 4) * 8192, lane, ph_); \
    DMA_KV((T) + 2, (T) & 1, (T), (T) & 1); \
    SBAR(); \
    qkt(PN0, PN1, K_lds + (((T) + 1) & 1) * SHM_K, qr, r32, hi, cmapB); \
    softmax_full(PC0, PC1, m_reg, l_reg, alpha, AC0, AC1, AC2, AC3); \
    if (DOPV) pv_d0(o, vb0 + (((T) + 1) & 1) * SHM_V, AP0, AP1, AP2, AP3); \
    SBAR(); \
    RESC(alpha); \
    if (wid < 4) { asm volatile("s_waitcnt vmcnt(0) lgkmcnt(0)" ::: "memory"); } else { asm volatile("s_waitcnt lgkmcnt(0)" ::: "memory"); } \
    __builtin_amdgcn_s_barrier(); asm volatile("" ::: "memory"); } while (0)
  if (wid >= 4) __builtin_amdgcn_s_setprio(1);
  HALF(0, pA0, pA1, pB0, pB1, aA0, aA1, aA2, aA3, aB0, aB1, aB2, aB3, false);
  for (int t = 1; t + 1 < NT; t += 2) {
    HALF(t, pB0, pB1, pA0, pA1, aB0, aB1, aB2, aB3, aA0, aA1, aA2, aA3, true);
    HALF(t + 1, pA0, pA1, pB0, pB1, aA0, aA1, aA2, aA3, aB0, aB1, aB2, aB3, true);
  }
  HALF(NT - 1, pB0, pB1, pA0, pA1, aB0, aB1, aB2, aB3, aA0, aA1, aA2, aA3, true);
  pv_d0(o, vb0 + SHM_V, aB0, aB1, aB2, aB3);
  __builtin_amdgcn_s_setprio(0);
#undef HALF
#undef DMA_KV
#undef TSYNC
#undef RESC
  if (hi == 0) li_l[r32] = l_reg; asm volatile("s_waitcnt lgkmcnt(0)" ::: "memory");
  float rli[16];
#pragma unroll
  for (int r = 0; r < 16; ++r) rli[r] = __builtin_amdgcn_rcpf(li_l[crow(r, hi)]);
  __syncthreads();
  float* X = (float*)lds + qw * (32 * 128);
  if (map == 1) {
#pragma unroll
    for (int d0 = 0; d0 < 4; ++d0)
#pragma unroll
      for (int r = 0; r < 16; ++r) X[crow(r, hi) * 128 + d0 * 32 + r32] = o[d0][r] * rli[r] * lam;
  }
  __syncthreads();
  if (map == 0) {
    float ss[16];
#pragma unroll
    for (int r = 0; r < 16; ++r) ss[r] = 0.f;
#pragma unroll
    for (int d0 = 0; d0 < 4; ++d0)
#pragma unroll
      for (int r = 0; r < 16; ++r) { const float v = o[d0][r] * rli[r] - X[crow(r, hi) * 128 + d0 * 32 + r32]; o[d0][r] = v; ss[r] += v * v; }
#pragma unroll
    for (int r = 0; r < 16; ++r) {
      ss[r] = half32_sum(ss[r]);
      ss[r] = 0.8f * __builtin_amdgcn_rsqf(ss[r] * (1.0f / 128.0f) + EPSN); }
    int r32e = r32; asm volatile("" : "+v"(r32e));
    float gv[4];
#pragma unroll
    for (int d0 = 0; d0 < 4; ++d0) gv[d0] = subg[d0 * 32 + r32e];
    bf16_t* Ow = Y1b + (size_t)(qrow0 + qw * 32) * DM + h * 128 + r32e;
#pragma unroll
    for (int r = 0; r < 16; ++r) { const int orow = crow(r, hi);
#pragma unroll
      for (int d0 = 0; d0 < 4; ++d0) { const unsigned w = cvt_pk_bf16(o[d0][r] * ss[r] * gv[d0], 0.f); Ow[(size_t)orow * DM + d0 * 32] = (bf16_t)(w & 0xffffu); } }
  }
  __syncthreads();
}
#undef KSWZ
#undef SBAR
}
struct Args { const float* in[33]; float* out; unsigned char* ws; int ph_lo, ph_hi; };
struct Frame {
    LAS unsigned char* lds; unsigned char* ldsg;
    int tid, lane, wave, G, vcu, gw, ngw;
    unsigned char* ws; float* out;
    const struct Args* a;
};
__device__ __forceinline__ void tok_decode(int r, int& b, bool& ctx, int& p) { b = r / SP; const int q = r - b * SP; ctx = q < CTXL; p = ctx ? q : q - CTXL; }

__device__ __forceinline__ void row_load(const float* row, int lane, f32x4 (&v)[4]) {
    const f32x4* p = (const f32x4*)row + lane;
#pragma unroll
    for (int j = 0; j < 4; ++j) v[j] = p[64 * j];
}
__device__ __forceinline__ void row_load_bf16(const bf16_t* row, int lane, f32x4 (&v)[4]) {
    const u32x2* p = (const u32x2*)row + lane;
#pragma unroll
    for (int j = 0; j < 4; ++j) { const u32x2 w = p[64 * j]; v[j] = (f32x4){bflo(w.x), bfhi(w.x), bflo(w.y), bfhi(w.y)}; }
}
__device__ __forceinline__ float row_sumsq(const f32x4 (&v)[4]) { float s = 0.f;
#pragma unroll
    for (int j = 0; j < 4; ++j) s += (v[j].x * v[j].x + v[j].y * v[j].y) + (v[j].z * v[j].z + v[j].w * v[j].w);
    return wave_sum(s); }
__device__ __forceinline__ void row_norm_mod(f32x4 (&v)[4], float rstd, const float* g, const float* shift, const float* scale, int lane) {
#pragma unroll
    for (int j = 0; j < 4; ++j) { const int c = 4 * lane + 256 * j; const f32x4 gg = *(const f32x4*)(g + c), sh = *(const f32x4*)(shift + c), sc = *(const f32x4*)(scale + c);
        v[j] = v[j] * rstd * gg * (sc + 1.0f) + sh; }
}
__device__ __forceinline__ void row_store_fp8(unsigned char* row, int lane, const f32x4 (&v)[4]) {
    unsigned* p = (unsigned*)row + lane;
#pragma unroll
    for (int j = 0; j < 4; ++j) p[64 * j] = pk4_fp8(v[j].x, v[j].y, v[j].z, v[j].w);
}
__device__ __forceinline__ void row_store_bf16(bf16_t* row, int lane, const f32x4 (&v)[4]) {
    u32x2* p = (u32x2*)row + lane;
#pragma unroll
    for (int j = 0; j < 4; ++j) { u32x2 w; w.x = cvt_pk_bf16(v[j].x, v[j].y); w.y = cvt_pk_bf16(v[j].z, v[j].w); p[64 * j] = w; }
}

__device__ __forceinline__ void phase_norm1_l0(Frame& F) {
    const float* x = F.a->in[0]; const float* cx = F.a->in[2]; const float* g = F.a->in[6]; const float* MOD = (const float*)(F.ws + WS_MOD); bf16_t* A1 = (bf16_t*)(F.ws + WS_A1);
    const int r0 = (int)(((long)F.gw * NTOK) / F.ngw), r1 = (int)(((long)(F.gw + 1) * NTOK) / F.ngw);
    for (int r = r0; r < r1; ++r) { int b, p; bool ctx; tok_decode(r, b, ctx, p);
        const float* hrow = ctx ? cx + ((size_t)b * CTXL + p) * DM : x + ((size_t)b * SEQ + p) * DM; const float* md = MOD + (ctx ? 4 : b) * 6144;
        f32x4 v[4]; row_load(hrow, F.lane, v); const float rstd = __builtin_amdgcn_rsqf(row_sumsq(v) * (1.0f / DM) + EPSN);
        row_norm_mod(v, rstd, g, md, md + 1024, F.lane); row_store_bf16(A1 + (size_t)r * DM, F.lane, v); }
}

__device__ __forceinline__ void phase_norm2_router(Frame& F, int layer, bool with_ctx) {
    const float* g = F.a->in[7] + layer * DM; const float* rw = F.a->in[8] + (size_t)layer * DM * NEXP; const float* MOD = (const float*)(F.ws + WS_MOD) + layer * 5 * 6144;
    bf16_t* A1 = (bf16_t*)(F.ws + WS_A1); float* AFF = (float*)(F.ws + WS_AFF); float* AFFC = (float*)(F.ws + WS_AFFC);
    const bf16_t* HB = (const bf16_t*)(F.ws + WS_HB);
    LAS float* RT = (LAS float*)F.lds;
    { f32x4 t[8];
#pragma unroll
      for (int u = 0; u < 8; ++u) { const int idx = F.tid + u * NTHR; t[u] = *(const f32x4*)(rw + (idx >> 2) * 16 + (idx & 3) * 4); }
#pragma unroll
      for (int u = 0; u < 8; ++u) { const int idx = F.tid + u * NTHR; const int d = idx >> 2, q = idx & 3; const int ln = (d & 255) >> 2, i = d & 3, j = d >> 8;
        *(LAS f32x4*)(RT + ((j * 4 + i) * 64 + ln) * 20 + q * 4) = t[u]; } }
    __syncthreads();
    int myexp; { float ids[16];
#pragma unroll
        for (int e = 0; e < 16; ++e) ids[e] = (F.lane == 0) ? (float)e : 0.f;
        myexp = (int)(reduce_scatter16(ids, F.lane) + 0.5f); }
    const int NV = with_ctx ? NTOK : NLAT;
    const int i0 = (int)(((long)F.gw * NV) / F.ngw), i1 = (int)(((long)(F.gw + 1) * NV) / F.ngw);
    for (int ix = i0; ix < i1; ix += 2) { const bool hasB = (ix + 1 < i1); const int ixb = hasB ? ix + 1 : ix;
        const int rA = with_ctx ? ix : (ix / SEQ) * SP + CTXL + (ix % SEQ), rB = with_ctx ? ixb : (ixb / SEQ) * SP + CTXL + (ixb % SEQ);
        int bA, pA, bB, pB; bool cA, cB; tok_decode(rA, bA, cA, pA); tok_decode(rB, bB, cB, pB);
        const float* mdA = MOD + (cA ? 4 : bA) * 6144; const float* mdB = MOD + (cB ? 4 : bB) * 6144;
        f32x4 vA[4], vB[4]; row_load_bf16(HB + (size_t)rA * DM, F.lane, vA); row_load_bf16(HB + (size_t)rB * DM, F.lane, vB);
        const float rsA = __builtin_amdgcn_rsqf(row_sumsq(vA) * (1.0f / DM) + EPSN), rsB = __builtin_amdgcn_rsqf(row_sumsq(vB) * (1.0f / DM) + EPSN);
        row_norm_mod(vA, rsA, g, mdA + 3072, mdA + 4096, F.lane); row_norm_mod(vB, rsB, g, mdB + 3072, mdB + 4096, F.lane);
        row_store_fp8((unsigned char*)A1 + (size_t)rA * DM, F.lane, vA);
        if (hasB) row_store_fp8((unsigned char*)A1 + (size_t)rB * DM, F.lane, vB);
        float lgA[16], lgB[16];
#pragma unroll
        for (int e = 0; e < 16; ++e) { lgA[e] = 0.f; lgB[e] = 0.f; }
        int rtoff = F.lane * 20; asm volatile("" : "+v"(rtoff));
#pragma unroll
        for (int j = 0; j < 4; ++j)
#pragma unroll
            for (int i = 0; i < 4; ++i) { const float xa = vA[j][i], xb = vB[j][i]; const LAS f32x4* wp = (const LAS f32x4*)(RT + (j * 4 + i) * 64 * 20 + rtoff);
#pragma unroll
                for (int q = 0; q < 4; ++q) { const f32x4 w = wp[q];
                    lgA[4 * q + 0] += xa * w.x; lgA[4 * q + 1] += xa * w.y; lgA[4 * q + 2] += xa * w.z; lgA[4 * q + 3] += xa * w.w;
                    lgB[4 * q + 0] += xb * w.x; lgB[4 * q + 1] += xb * w.y; lgB[4 * q + 2] += xb * w.z; lgB[4 * q + 3] += xb * w.w; } }
        const float tA = reduce_scatter16(lgA, F.lane), tB = reduce_scatter16(lgB, F.lane);
        const float mA = wave_max(tA), mB = wave_max(tB); const float eA = __expf(tA - mA), eB = __expf(tB - mB);
        const float sA = wave_sum(eA) * 0.25f, sB = wave_sum(eB) * 0.25f;
        if ((F.lane & 3) == 0) { const float mine = eA / sA; if (cA) AFFC[((size_t)bA * NEXP + myexp) * CTXL + pA] = mine; else AFF[((size_t)bA * NEXP + myexp) * SEQ + pA] = mine;
            if (hasB) { const float mineB = eB / sB; if (cB) AFFC[((size_t)bB * NEXP + myexp) * CTXL + pB] = mineB; else AFF[((size_t)bB * NEXP + myexp) * SEQ + pB] = mineB; } }
    }
    __syncthreads();
}

__device__ __forceinline__ void select_unit(Frame& F, const float* aff, int n, int cap, int* slot_of, int* tok, int tok_base) {
    volatile LAS int* red = (volatile LAS int*)F.lds;
    const int tid = F.tid, lane = F.lane, wid = F.wave;
    unsigned v[16];
    const int i0 = tid * 16;
#pragma unroll
    for (int q = 0; q < 4; ++q) { u32x4 t = {0u, 0u, 0u, 0u}; if (i0 + 4 * q < n) t = *(const u32x4*)((const unsigned*)aff + i0 + 4 * q); v[4 * q] = t.x; v[4 * q + 1] = t.y; v[4 * q + 2] = t.z; v[4 * q + 3] = t.w; }
    unsigned T = 0u; int buf = 0;
    for (int bit = 30; bit >= 0; --bit) { const unsigned cand = T | (1u << bit); int c = 0;
#pragma unroll
        for (int i = 0; i < 16; ++i) c += (v[i] >= cand) ? 1 : 0;
        c = wave_sum_i(c); if (lane == 0) red[buf * 8 + wid] = c;
        __syncthreads();
        int tot = 0;
#pragma unroll
        for (int w = 0; w < 8; ++w) tot += red[buf * 8 + w];
        if (tot >= cap) T = cand; buf ^= 1; }
    int cg = 0, ce = 0;
#pragma unroll
    for (int i = 0; i < 16; ++i) { cg += (v[i] > T) ? 1 : 0; ce += (v[i] == T) ? 1 : 0; }
    int sg = cg, se = ce;
#pragma unroll
    for (int o = 1; o < 64; o <<= 1) { const int tg = __shfl_up(sg, o), te = __shfl_up(se, o); if (lane >= o) { sg += tg; se += te; } }
    __syncthreads();
    if (lane == 63) { red[32 + wid] = sg; red[48 + wid] = se; }
    __syncthreads();
    int offg = 0, offe = 0, totg = 0;
#pragma unroll
    for (int w = 0; w < 8; ++w) { const int a = red[32 + w], e2 = red[48 + w]; if (w < wid) { offg += a; offe += e2; } totg += a; }
    const int exg = offg + sg - cg, exe = offe + se - ce;
    const int need_eq = cap - totg;
    int take_e = need_eq - exe; take_e = take_e < 0 ? 0 : (take_e > ce ? ce : take_e);
    const int selcnt = cg + take_e;
    int ss = selcnt;
#pragma unroll
    for (int o = 1; o < 64; o <<= 1) { const int t2 = __shfl_up(ss, o); if (lane >= o) ss += t2; }
    __syncthreads();
    if (lane == 63) red[32 + wid] = ss;
    __syncthreads();
    int offs = 0;
#pragma unroll
    for (int w = 0; w < 8; ++w) { const int a = red[32 + w]; if (w < wid) offs += a; }
    int slot = offs + ss - selcnt; int eq_left = take_e;
    (void)exg;
    int so[16];
#pragma unroll
    for (int i = 0; i < 16; ++i) { bool sel = v[i] > T; if (v[i] == T && eq_left > 0) { sel = true; --eq_left; }
        so[i] = sel ? slot : -1; if (sel) { if (i0 + i < n) tok[slot] = tok_base + i0 + i; ++slot; } }
    if (i0 < n) {
#pragma unroll
        for (int q = 0; q < 4; ++q) *(u32x4*)((unsigned*)slot_of + i0 + 4 * q) = (u32x4){(unsigned)so[4 * q], (unsigned)so[4 * q + 1], (unsigned)so[4 * q + 2], (unsigned)so[4 * q + 3]}; }
    __syncthreads();
}
__device__ __forceinline__ void phase_select(Frame& F, bool with_ctx) {
    const float* AFF = (const float*)(F.ws + WS_AFF); const float* AFFC = (const float*)(F.ws + WS_AFFC);
    int* SLOT = (int*)(F.ws + WS_SLOT); int* SLOTC = (int*)(F.ws + WS_SLOTC); int* TOK = (int*)(F.ws + WS_TOK);
    const int nu = with_ctx ? 128 : 64;
    for (int u = blockIdx.x; u < nu; u += F.G) {
        if (u < 64) { const int b = u >> 4, e = u & 15;
            select_unit(F, AFF + ((size_t)b * NEXP + e) * SEQ, SEQ, CAPL, SLOT + ((size_t)b * NEXP + e) * SEQ, TOK + e * XROWS + b * CAPL, b * SP + CTXL);
        } else { const int b = (u - 64) >> 4, e = u & 15;
            select_unit(F, AFFC + ((size_t)b * NEXP + e) * CTXL, CTXL, CAPC, SLOTC + ((size_t)b * NEXP + e) * CTXL, TOK + e * XROWS + 4096 + b * CAPC, b * SP); }
    }
}
__device__ __forceinline__ void phase_gather(Frame& F, bool with_ctx) {
    const bf16_t* A1 = (const bf16_t*)(F.ws + WS_A1); unsigned char* XS = (unsigned char*)(F.ws + WS_XS); const int* TOK = (const int*)(F.ws + WS_TOK);
    const int rows_e = with_ctx ? 4224 : 4096, total = NEXP * rows_e;
    for (int it = F.gw; it < total; it += F.ngw) { const int e = it / rows_e, row = it - e * rows_e; const int tk = TOK[e * XROWS + row];
        const u32x4* src = (const u32x4*)(A1 + (size_t)tk * DM) + 2 * F.lane; const u32x4 a = src[0], c = src[1];
        u32x4 o; o.x = pk4_fp8(bflo(a.x), bfhi(a.x), bflo(a.y), bfhi(a.y)); o.y = pk4_fp8(bflo(a.z), bfhi(a.z), bflo(a.w), bfhi(a.w));
        o.z = pk4_fp8(bflo(c.x), bfhi(c.x), bflo(c.y), bfhi(c.y)); o.w = pk4_fp8(bflo(c.z), bfhi(c.z), bflo(c.w), bfhi(c.w));
        *((u32x4*)(XS + ((size_t)e * XROWS + row) * DM) + F.lane) = o; }
}
__device__ __forceinline__ void phase_combine(Frame& F, int layer, bool with_ctx, int mode, bool dry = false) {
    const float* MOD = (const float*)(F.ws + WS_MOD) + layer * 5 * 6144;
    const float* AFF = (const float*)(F.ws + WS_AFF); const float* AFFC = (const float*)(F.ws + WS_AFFC);
    const int* SLOT = (const int*)(F.ws + WS_SLOT); const int* SLOTC = (const int*)(F.ws + WS_SLOTC);
    const unsigned char* YS = (const unsigned char*)(F.ws + WS_XS); bf16_t* A1 = (bf16_t*)(F.ws + WS_A1);
    float* hl = F.out; bf16_t* HB = (bf16_t*)(F.ws + WS_HB);
    const float* gnext = (mode == 0) ? F.a->in[6] + (layer + 1) * DM : F.a->in[32]; const float* MODN = (const float*)(F.ws + WS_MOD) + (layer + 1) * 5 * 6144;
    int r0 = (int)(((long)F.gw * NTOK) / F.ngw); const int r1 = (int)(((long)(F.gw + 1) * NTOK) / F.ngw);
    const int le = F.lane & 15;
#define CMB_REQ(r, SL, AF, HV) do { int b_, p_; bool c_; tok_decode((r), b_, c_, p_); \
        const size_t o_ = c_ ? ((size_t)b_ * NEXP + le) * CTXL + p_ : ((size_t)b_ * NEXP + le) * SEQ + p_; \
        SL = c_ ? SLOTC[o_] : SLOT[o_]; AF = c_ ? AFFC[o_] : AFF[o_]; \
        row_load_bf16(HB + (size_t)(r) * DM, F.lane, HV); } while (0)
    if (!with_ctx) { int b, p; bool ctx; while (r0 < r1) { tok_decode(r0, b, ctx, p); if (!ctx) break; ++r0; } }
    if (r0 >= r1) return;
    int sl_n; float af_n; f32x4 hv_n[4];
    CMB_REQ(r0, sl_n, af_n, hv_n);
    for (int r = r0; r < r1; ++r) { int b, p; bool ctx; tok_decode(r, b, ctx, p);
        if (ctx && !with_ctx) continue;
        const int sl = sl_n; const float af = af_n; f32x4 v[4];
#pragma unroll
        for (int j = 0; j < 4; ++j) v[j] = hv_n[j];
        { int rn = r + 1; if (!with_ctx) { int b2, p2; bool c2; while (rn < r1) { tok_decode(rn, b2, c2, p2); if (!c2) break; ++rn; } }
          if (rn < r1) CMB_REQ(rn, sl_n, af_n, hv_n); }
        const float* md = MOD + (ctx ? 4 : b) * 6144;
        f32x4 acc[4];
#pragma unroll
        for (int j = 0; j < 4; ++j) acc[j] = (f32x4){0.f, 0.f, 0.f, 0.f};
        unsigned mask = (unsigned)(__ballot(sl >= 0) & 0xffffull);
        const size_t rowbase = ctx ? (size_t)(4096 + b * CAPC) : (size_t)(b * CAPL);
        while (mask) {
            int e[4]; float gq[4]; const unsigned* yp[4];
#pragma unroll
            for (int q = 0; q < 4; ++q) { const bool ok = mask != 0u; const int eb = ok ? (int)__builtin_ctz(mask) : 0; mask = ok ? (mask & (mask - 1u)) : 0u;
                e[q] = ok ? eb : e[0]; const int s = __shfl(sl, e[q]); gq[q] = ok ? __shfl(af, e[q]) * (1.0f / pg8::YS_SCALE) : 0.f;
                yp[q] = (const unsigned*)(YS + ((size_t)e[q] * XROWS + rowbase + (s < 0 ? 0 : s)) * DM) + F.lane; }
            unsigned w[4][4];
#pragma unroll
            for (int q = 0; q < 4; ++q)
#pragma unroll
                for (int j = 0; j < 4; ++j) w[q][j] = yp[q][64 * j];
#pragma unroll
            for (int q = 0; q < 4; ++q)
#pragma unroll
                for (int j = 0; j < 4; ++j) { const auto lo = __builtin_amdgcn_cvt_pk_f32_fp8((int)w[q][j], false), hi2 = __builtin_amdgcn_cvt_pk_f32_fp8((int)w[q][j], true);
                    acc[j].x += gq[q] * lo[0]; acc[j].y += gq[q] * lo[1]; acc[j].z += gq[q] * hi2[0]; acc[j].w += gq[q] * hi2[1]; }
        }
#pragma unroll
        for (int j = 0; j < 4; ++j) { const f32x4 gt = *(const f32x4*)(md + 5120 + 4 * F.lane + 256 * j); v[j] = v[j] + gt * acc[j]; }
        const float rstd = __builtin_amdgcn_rsqf(row_sumsq(v) * (1.0f / DM) + EPSN);
        bf16_t* A1w = A1; (void)dry;
        if (mode == 0) {
            row_store_bf16(HB + (size_t)r * DM, F.lane, v);
            const float* mdn = MODN + (ctx ? 4 : b) * 6144;
            row_norm_mod(v, rstd, gnext, mdn, mdn + 1024, F.lane); row_store_fp8((unsigned char*)A1w + (size_t)r * DM, F.lane, v);
        } else {
#pragma unroll
            for (int j = 0; j < 4; ++j) { const f32x4 gg = *(const f32x4*)(gnext + 4 * F.lane + 256 * j); ((f32x4*)(hl + ((size_t)b * SEQ + p) * DM) + F.lane)[64 * j] = v[j] * rstd * gg; }
        }
    }
#undef CMB_REQ
}
__device__ __forceinline__ void phase_pool(Frame& F) {
    const bf16_t* Z = (const bf16_t*)(F.ws + WS_Z); bf16_t* Y1 = (bf16_t*)(F.ws + WS_Y1);
    const int skip = (F.G == 256) ? 32 : 0; if (F.vcu < skip) return;
    const int pw = (F.vcu - skip) * NWAVES + F.wave, npw = (F.G - skip) * NWAVES;
    const int r0 = (int)(((long)pw * NTOK) / npw), r1 = (int)(((long)(pw + 1) * NTOK) / npw);
    const int half = 1 << (F.lane >> 4);
    for (int r = r0; r < r1; ++r) { int b, p; bool ctx; tok_decode(r, b, ctx, p); const int n = ctx ? CTXL : SEQ; const int rbase = r - p;
        int lo = p - half; lo = lo < 0 ? 0 : lo; int hi = p + half - 1; hi = hi > n - 1 ? n - 1 : hi;
        float s[8];
#pragma unroll
        for (int i = 0; i < 8; ++i) s[i] = 0.f;
        float own[8];
#pragma unroll
        for (int i = 0; i < 8; ++i) own[i] = 0.f;
        u32x4 w16[16];
#pragma unroll
        for (int j = 0; j < 16; ++j) { int q = p + j - 8; q = q < 0 ? 0 : (q > n - 1 ? n - 1 : q); w16[j] = *((const u32x4*)(Z + (size_t)(rbase + q) * 2048 + 1536) + F.lane); }
#pragma unroll
        for (int j = 0; j < 16; ++j) { const int q = p + j - 8; const u32x4 w = w16[j];
            float f[8] = {bflo(w.x), bfhi(w.x), bflo(w.y), bfhi(w.y), bflo(w.z), bfhi(w.z), bflo(w.w), bfhi(w.w)};
            const bool in = (q >= lo) && (q <= hi);
#pragma unroll
            for (int i = 0; i < 8; ++i) { s[i] += in ? f[i] : 0.f; if (j == 8) own[i] = f[i]; } }
        const float inv = 1.0f / (float)(hi - lo + 1);
        f32x4 o0 = {s[0] * inv - own[0], s[1] * inv - own[1], s[2] * inv - own[2], s[3] * inv - own[3]}, o1 = {s[4] * inv - own[4], s[5] * inv - own[5], s[6] * inv - own[6], s[7] * inv - own[7]};
        *((u32x4*)(Y1 + (size_t)r * DM + 512) + F.lane) = pg8::pack8(o0, o1); }
}
__device__ __forceinline__ void phase_attn(Frame& F) {
    const bf16_t* Z = (const bf16_t*)(F.ws + WS_Z); bf16_t* Y1 = (bf16_t*)(F.ws + WS_Y1); const float lam = *(const float*)(F.ws + WS_LAM); const float* subg = F.a->in[18];
    const dattn::CvtCtx CC{F.a->in[9], F.a->in[10], F.a->in[11], (unsigned char*)(F.ws + WS_GU), (unsigned char*)(F.ws + WS_DN), (int)blockIdx.x * 4 + (F.wave & 3), F.G * 4, F.wave >= 4 ? 2 * 16 * 3 * 1024 : 0};
    dattn::CvtState CS{0, -1, 0, (int)(blockIdx.x >> 3)};
    for (int L = F.vcu; L < 1024 + 32; L += F.G) {
        if (L < 1024) { const int bh = L >> 6, qb = L & 63; const int b = bh >> 2, h = bh & 3;
            dattn::diff_attn_unit_p3(Z + (size_t)b * SP * 2048, CTXL + qb * 128, h, SP, Y1 + (size_t)b * SP * DM, lam, subg, (char*)F.ldsg, CC, CS);
        } else { const int l = L - 1024; const int bh = l >> 1, qb = l & 1; const int b = bh >> 2, h = bh & 3;
            dattn::diff_attn_unit_p3(Z + (size_t)b * SP * 2048, qb * 128, h, CTXL, Y1 + (size_t)b * SP * DM, lam, subg, (char*)F.ldsg, CC, CS); }
    }
    if (F.wave >= 4) dattn::cvt_drain(CC, CS, (LAS char*)F.ldsg + 67584 + (F.wave - 4) * 8192, F.lane);
    phase_pool(F);
}
__device__ __forceinline__ void p0_mod(Frame& F, int l0, int l1, int b0, int nb) {
    if ((int)blockIdx.x < b0 || (int)blockIdx.x >= b0 + nb) return;
    LAS float* cond = (LAS float*)F.lds;
    LAS float* red = cond + 5 * 1024;
    const float* c = F.a->in[1]; const float* cc = F.a->in[3]; const float* aw = F.a->in[4]; const float* ab = F.a->in[5]; float* MOD = (float*)(F.ws + WS_MOD);
    { float x[10];
#pragma unroll
      for (int q = 0; q < 10; ++q) { const int i = F.tid + q * NTHR; x[q] = (q < 8) ? c[i] : cc[i - 4096]; }
#pragma unroll
      for (int q = 0; q < 10; ++q) cond[F.tid + q * NTHR] = siluf_(x[q]); }
    __syncthreads();
    for (int it = l0 * 96 + (int)blockIdx.x - b0; it < l1 * 96; it += nb) { const int layer = it / 96, cb = it - layer * 96; const int col = cb * 64 + F.lane;
        const float* W = aw + (size_t)layer * DM * 6144 + col; float acc[5] = {0.f, 0.f, 0.f, 0.f, 0.f};
        const int k0 = F.wave * 128;
#pragma unroll 16
        for (int k = k0; k < k0 + 128; ++k) { const float w = W[(size_t)k * 6144];
#pragma unroll
            for (int r = 0; r < 5; ++r) acc[r] += cond[r * 1024 + k] * w; }
#pragma unroll
        for (int r = 0; r < 5; ++r) red[(F.wave * 5 + r) * 64 + F.lane] = acc[r];
        __syncthreads();
        if (F.tid < 320) { const int r = F.tid >> 6, ln = F.tid & 63; float s = 0.f;
#pragma unroll
            for (int w = 0; w < 8; ++w) s += red[(w * 5 + r) * 64 + ln];
            MOD[((size_t)layer * 5 + r) * 6144 + cb * 64 + ln] = s + ab[layer * 6144 + cb * 64 + ln]; }
        __syncthreads();
    }
}
__device__ __forceinline__ void p0_transpose_item(const float* Wb, int ldw, bf16_t* Db, int ldd, LAS float* scr, int lane) {
#pragma unroll 8
    for (int i = 0; i < 32; ++i) { const int kk = 2 * i + (lane >> 5); scr[kk * 33 + (lane & 31)] = Wb[(size_t)kk * ldw + (lane & 31)]; }
    LDS_WAIT(); asm volatile("" ::: "memory");
    const int c = lane & 7;
#pragma unroll
    for (int j = 0; j < 4; ++j) { const int n = (lane >> 3) + 8 * j; const LAS float* s = scr + (8 * c) * 33 + n;
        u32x4 o; o.x = cvt_pk_bf16(s[0 * 33], s[1 * 33]); o.y = cvt_pk_bf16(s[2 * 33], s[3 * 33]); o.z = cvt_pk_bf16(s[4 * 33], s[5 * 33]); o.w = cvt_pk_bf16(s[6 * 33], s[7 * 33]);
        *(u32x4*)(Db + (size_t)n * ldd + 8 * c) = o; }
    LDS_WAIT(); asm volatile("" ::: "memory");
}
__device__ __forceinline__ void p0_transpose_item_f8(const float* Wb, int ldw, unsigned char* Db, int ldd, float sc, LAS float* scr, int lane) {
#pragma unroll 8
    for (int i = 0; i < 32; ++i) { const int kk = 2 * i + (lane >> 5); scr[kk * 33 + (lane & 31)] = Wb[(size_t)kk * ldw + (lane & 31)] * sc; }
    LDS_WAIT(); asm volatile("" ::: "memory");
    const int c = lane & 3;
#pragma unroll
    for (int j = 0; j < 2; ++j) { const int n = (lane >> 2) + 16 * j; const LAS float* s = scr + (16 * c) * 33 + n;
        u32x4 o; o.x = pk4_fp8(s[0 * 33], s[1 * 33], s[2 * 33], s[3 * 33]); o.y = pk4_fp8(s[4 * 33], s[5 * 33], s[6 * 33], s[7 * 33]);
        o.z = pk4_fp8(s[8 * 33], s[9 * 33], s[10 * 33], s[11 * 33]); o.w = pk4_fp8(s[12 * 33], s[13 * 33], s[14 * 33], s[15 * 33]);
        *(u32x4*)(Db + (size_t)n * ldd + 16 * c) = o; }
    LDS_WAIT(); asm volatile("" ::: "memory");
}
__device__ __forceinline__ void p0_weights(Frame& F, int lo, int hi, int w0, int nw) {
    LAS float* scr = (LAS float*)(F.lds + 32768 + F.wave * 8704);
    constexpr int I_IN = 16 * 64, I_OUT = 8 * 32, I_S = 16 * 32, I_E = 16 * 64;
    constexpr int NITEMS = I_IN + I_OUT + 3 * I_S;
    bf16_t* WIN = (bf16_t*)(F.ws + WS_WIN); bf16_t* WOUT = (bf16_t*)(F.ws + WS_WOUT); unsigned char* GU = (unsigned char*)(F.ws + WS_GU); unsigned char* DN = (unsigned char*)(F.ws + WS_DN);
    if (F.gw < w0 || F.gw >= w0 + nw) return;
    if (hi > NITEMS) hi = NITEMS;
    for (int it = lo + F.gw - w0; it < hi; it += nw) {
        int r = it;
        if (r < I_IN) { const int kb = r / 64, nb = r % 64; p0_transpose_item(F.a->in[12] + (size_t)(kb * 64) * 2048 + nb * 32, 2048, WIN + (size_t)(nb * 32) * 1024 + kb * 64, 1024, scr, F.lane); continue; } r -= I_IN;
        if (r < I_OUT) { const int kb = r / 32, nb = r % 32; p0_transpose_item(F.a->in[13] + (size_t)(kb * 64) * 1024 + nb * 32, 1024, WOUT + (size_t)(nb * 32) * 1024 + kb * 64, 1024, scr, F.lane); continue; } r -= I_OUT;
        if (r < 3 * I_S) { const int m = r / I_S, q = r % I_S, kb = q / 32, nb = q % 32; const float* W = m == 0 ? F.a->in[21] : (m == 1 ? F.a->in[30] : F.a->in[31]);
            bf16_t* Dst = (bf16_t*)(F.ws + (m == 0 ? WS_SWIN : (m == 1 ? WS_SWGLU : WS_SWOUT)));
            if (m != 1) p0_transpose_item_f8(W + (size_t)(kb * 64) * 1024 + nb * 32, 1024, (unsigned char*)Dst + (size_t)(nb * 32) * 1024 + kb * 64, 1024, 32.f, scr, F.lane);
            else p0_transpose_item(W + (size_t)(kb * 64) * 1024 + nb * 32, 1024, Dst + (size_t)(nb * 32) * 1024 + kb * 64, 1024, scr, F.lane);
            continue; }
        (void)r;
    }
}
__device__ __forceinline__ void p0_poolfold(Frame& F, int w0, int nw) {
    const float* pw = F.a->in[19]; const float* ps = F.a->in[20]; const float* wo = F.a->in[13]; bf16_t* WOUT = (bf16_t*)(F.ws + WS_WOUT);
    if (F.gw < w0 || F.gw >= w0 + nw) return;
    for (int it = F.gw - w0; it < 4 * 16 * 16; it += nw) { const int g = it >> 8, cb = (it >> 4) & 15, nb = it & 15; const int n = nb * 64 + F.lane;
        float acc[8] = {0.f, 0.f, 0.f, 0.f, 0.f, 0.f, 0.f, 0.f};
#pragma unroll 16
        for (int e = 0; e < 128; ++e) { const float w = wo[(size_t)(512 + g * 128 + e) * 1024 + n] * ps[g * 128 + e];
#pragma unroll
            for (int i = 0; i < 8; ++i) acc[i] += pw[((size_t)g * 128 + cb * 8 + i) * 128 + e] * w; }
        u32x4 o; o.x = cvt_pk_bf16(acc[0], acc[1]); o.y = cvt_pk_bf16(acc[2], acc[3]); o.z = cvt_pk_bf16(acc[4], acc[5]); o.w = cvt_pk_bf16(acc[6], acc[7]);
        *(u32x4*)(WOUT + (size_t)n * 1024 + 512 + g * 128 + cb * 8) = o; }
}
__device__ __forceinline__ float expf_(float x) { return __builtin_amdgcn_exp2f(x * 1.4426950408889634f); }
__device__ __forceinline__ float sin2pi_(float rev) { return __builtin_amdgcn_sinf(__builtin_amdgcn_fractf(rev)); }
__device__ __forceinline__ float cos2pi_(float rev) { return __builtin_amdgcn_cosf(__builtin_amdgcn_fractf(rev)); }
__device__ __forceinline__ void p0_tables(Frame& F, int b0, int nb) {
    if ((int)blockIdx.x < b0 || (int)blockIdx.x >= b0 + nb) return;
    const int gt = ((int)blockIdx.x - b0) * NTHR + F.tid, NT_ = nb * NTHR;
    constexpr float INV2PI = 0.15915494309189535f;
    float* ropec = (float*)(F.ws + WS_ROPE); float* ropes = ropec + 128 * 16;
    for (int i = gt; i < 128 * 16; i += NT_) { const int pos = i >> 4, f = i & 15; const float inv = __builtin_amdgcn_exp2f(-(float)f * (13.287712379549449f / 16.0f)); const float rev = (float)pos * inv * INV2PI;
        ropec[i] = cos2pi_(rev); ropes[i] = sin2pi_(rev); }
    if (gt == 0) { float s1 = 0.f, s2 = 0.f; for (int i = 0; i < 64; ++i) { s1 += F.a->in[14][i] * F.a->in[15][i]; s2 += F.a->in[16][i] * F.a->in[17][i]; }
        *(float*)(F.ws + WS_LAM) = expf_(s1) - expf_(s2) + (0.8f - 0.6f); }
    float2* APOW = (float2*)(F.ws + WS_APOW); float2* BBAR = (float2*)(F.ws + WS_BBAR);
    for (int i = gt; i < 2 * SG * SN; i += NT_) {
        const int dg = i >> 6; const float lre = F.a->in[22][i], lim = F.a->in[23][i], dt = expf_(F.a->in[24][dg]);
        const float mag = expf_(lre * dt), rev = lim * dt * INV2PI, ar = mag * cos2pi_(rev), ai = mag * sin2pi_(rev);
        const float rden = 1.0f / (lre * lre + lim * lim); const float qr = ((ar - 1.0f) * lre + ai * lim) * rden, qi = (ai * lre - (ar - 1.0f) * lim) * rden;
#pragma unroll
        for (int c = 0; c < SC; ++c) { const float br = F.a->in[25][(size_t)i * SC + c], bi = F.a->in[26][(size_t)i * SC + c]; BBAR[(size_t)i * SC + c] = make_float2(qr * br - qi * bi, qr * bi + qi * br); }
        float pr = 1.0f, pi = 0.0f;
#pragma unroll 1
        for (int t = 0; t <= SL; ++t) { APOW[(size_t)i * (SL + 1) + t] = make_float2(pr, pi); const float nr = pr * ar - pi * ai, ni = pr * ai + pi * ar; pr = nr; pi = ni; }
    }
}
__device__ __forceinline__ void p1_ktab(Frame& F) {
    const int gt = blockIdx.x * NTHR + F.tid, NT_ = F.G * NTHR;
    const float2* APOW = (const float2*)(F.ws + WS_APOW); const float2* BBAR = (const float2*)(F.ws + WS_BBAR); float* KTAB = (float*)(F.ws + WS_KTAB);
    for (int i = gt; i < 2 * SG * 4 * 256; i += NT_) { const int cp = i & 15, c = (i >> 4) & 15, tau0 = ((i >> 8) & 3) * 8, dg = i >> 10;
        const float* cre = F.a->in[27] + ((size_t)dg * SC + c) * SN; const float* cim = F.a->in[28] + ((size_t)dg * SC + c) * SN; float s[8];
#pragma unroll
        for (int t = 0; t < 8; ++t) s[t] = 0.f;
#pragma unroll 8
        for (int n = 0; n < SN; ++n) { const float2* ap = APOW + ((size_t)dg * SN + n) * (SL + 1); const float2 a = ap[1], p0 = ap[tau0], bb = BBAR[((size_t)dg * SN + n) * SC + cp];
            const float cr = cre[n], ci = cim[n]; const float qr = cr * bb.x - ci * bb.y, qi = cr * bb.y + ci * bb.x; float px = p0.x, py = p0.y;
#pragma unroll
            for (int t = 0; t < 8; ++t) { s[t] += qr * px - qi * py; const float nx = px * a.x - py * a.y, ny = px * a.y + py * a.x; px = nx; py = ny; } }
#pragma unroll
        for (int t = 0; t < 8; ++t) KTAB[((((size_t)dg * SL + tau0 + t) * 16 + c) * 16) + cp] = s[t]; }
}
__device__ __forceinline__ void p2_operators(Frame& F) {
    const int skip = (F.G == 256) ? 32 : 0; if ((int)blockIdx.x < skip) return;
    const int gt = ((int)blockIdx.x - skip) * NTHR + F.tid, NT_ = (F.G - skip) * NTHR;
    const float2* APOW = (const float2*)(F.ws + WS_APOW); const float2* BBAR = (const float2*)(F.ws + WS_BBAR); const float* KTAB = (const float*)(F.ws + WS_KTAB);
    bf16_t* TQ = (bf16_t*)(F.ws + WS_TQ); bf16_t* POP = (bf16_t*)(F.ws + WS_POP); const float* dsk = F.a->in[29];
#pragma unroll 2
    for (int i = gt; i < SG * 512 * 64; i += NT_) { const int cb = i & 63, row = (i >> 6) & 511, g = i >> 15; const int t = row >> 4, c = row & 15; const int j = cb >> 1, cp0 = (cb & 1) * 8;
        const int ta = t - j, tb = j - t;
        const float* ka = KTAB + ((((size_t)0 * SG + g) * SL + (ta < 0 ? 0 : ta)) * 16 + c) * 16 + cp0;
        const float* kb = KTAB + ((((size_t)1 * SG + g) * SL + (tb < 0 ? 0 : tb)) * 16 + c) * 16 + cp0;
        const f32x4 a0 = *(const f32x4*)ka, a1 = *(const f32x4*)(ka + 4), b0 = *(const f32x4*)kb, b1 = *(const f32x4*)(kb + 4); const float d = dsk[g * 16 + c];
        const float fa = ta >= 0 ? 1.f : 0.f, fb = tb >= 0 ? 1.f : 0.f; const bool dg_ = (j == t) && ((c >> 3) == (cb & 1)); float o[8];
#pragma unroll
        for (int q = 0; q < 4; ++q) { o[q] = fa * a0[q] + fb * b0[q]; o[4 + q] = fa * a1[q] + fb * b1[q]; }
#pragma unroll
        for (int q = 0; q < 8; ++q) o[q] += (dg_ && q == (c & 7)) ? d : 0.f;
        u32x4 w; w.x = cvt_pk_bf16(o[0], o[1]); w.y = cvt_pk_bf16(o[2], o[3]); w.z = cvt_pk_bf16(o[4], o[5]); w.w = cvt_pk_bf16(o[6], o[7]);
        *(u32x4*)(TQ + ((size_t)g * 512 + row) * UK + cb * 8) = w; }
#pragma unroll 2
    for (int i = gt; i < SG * 512 * 32; i += NT_) { const int cbb = i & 31, row = (i >> 5) & 511, g = i >> 14; const int t = row >> 4, c = row & 15; float o[8];
        const int dir = cbb >> 4, n0 = (cbb & 15) * 4; const int dg = dir * SG + g; const int tau = dir == 0 ? t + 1 : SL - t;
#pragma unroll
        for (int q = 0; q < 4; ++q) { const int n = n0 + q; const float2 a = APOW[((size_t)dg * SN + n) * (SL + 1) + tau];
            const float cr = F.a->in[27][((size_t)dg * SC + c) * SN + n], ci = F.a->in[28][((size_t)dg * SC + c) * SN + n];
            o[2 * q] = cr * a.x - ci * a.y; o[2 * q + 1] = -(cr * a.y + ci * a.x); }
        u32x4 w; w.x = cvt_pk_bf16(o[0], o[1]); w.y = cvt_pk_bf16(o[2], o[3]); w.z = cvt_pk_bf16(o[4], o[5]); w.w = cvt_pk_bf16(o[6], o[7]);
        *(u32x4*)(TQ + ((size_t)g * 512 + row) * UK + (64 + cbb) * 8) = w; }
    for (int i = gt; i < SG * 256 * 64; i += NT_) { const int cb = i & 63, row = (i >> 6) & 255, g = i >> 14; const int dir = row >> 7, n = (row >> 1) & 63, im = row & 1; const int dg = dir * SG + g;
        const int j = cb >> 1, cp0 = (cb & 1) * 8; const int tau = dir == 0 ? SL - 1 - j : j; const float2 a = APOW[((size_t)dg * SN + n) * (SL + 1) + tau]; float o[8];
#pragma unroll
        for (int q = 0; q < 8; ++q) { const float2 bb = BBAR[((size_t)dg * SN + n) * SC + cp0 + q]; o[q] = im ? (a.x * bb.y + a.y * bb.x) : (a.x * bb.x - a.y * bb.y); }
        u32x4 w; w.x = cvt_pk_bf16(o[0], o[1]); w.y = cvt_pk_bf16(o[2], o[3]); w.z = cvt_pk_bf16(o[4], o[5]); w.w = cvt_pk_bf16(o[6], o[7]);
        *(u32x4*)(POP + ((size_t)g * 256 + row) * 512 + cb * 8) = w; }
}
__device__ __forceinline__ void phase_scan(Frame& F) {
    const float2* APOW = (const float2*)(F.ws + WS_APOW); const float* SLOC = (const float*)(F.ws + WS_SLOC); bf16_t* U = (bf16_t*)(F.ws + WS_U);
    if (F.tid >= 256) return;
    for (int i = blockIdx.x * 256 + F.tid; i < NB * SG * 2 * SN; i += F.G * 256) { const int n = i & 63, dir = (i >> 6) & 1, g = (i >> 7) & 63, b = i >> 13;
        const float2 aL = APOW[(((size_t)dir * SG + g) * SN + n) * (SL + 1) + SL];
        const float* sl = SLOC + (size_t)g * UROWS * 256 + dir * 128 + 2 * n; bf16_t* ub = U + (size_t)g * UROWS * UK + 512 + dir * 128 + 2 * n;
        float sr = 0.f, si = 0.f; f32x2 v[32];
#pragma unroll
        for (int q = 0; q < 8; ++q) { const int k = dir == 0 ? q : NCHC - 1 - q; v[q] = *(const f32x2*)(sl + (size_t)(1024 + b * NCHC + k) * 256); }
#pragma unroll
        for (int q = 0; q < 8; ++q) { const float nr = aL.x * sr - aL.y * si + v[q].x, ni = aL.x * si + aL.y * sr + v[q].y; sr = nr; si = ni; }
        for (int k0 = 0; k0 < NCHL; k0 += 32) {
#pragma unroll
            for (int q = 0; q < 32; ++q) { const int k = dir == 0 ? k0 + q : NCHL - 1 - k0 - q; v[q] = *(const f32x2*)(sl + (size_t)(b * NCHL + k) * 256); }
#pragma unroll
            for (int q = 0; q < 32; ++q) { const int k = dir == 0 ? k0 + q : NCHL - 1 - k0 - q; *(unsigned*)(ub + (size_t)(b * NCHL + k) * UK) = cvt_pk_bf16(sr, si);
                const float nr = aL.x * sr - aL.y * si + v[q].x, ni = aL.x * si + aL.y * sr + v[q].y; sr = nr; si = ni; }
        }
    }
}
constexpr int N_PHASES = 23;
__global__ void __launch_bounds__(NTHR, 2) mega_fwd(Args args) {
    extern __shared__ __attribute__((aligned(16))) unsigned char lds_raw[];
    Frame F;
    F.lds = (LAS unsigned char*)lds_raw; F.ldsg = lds_raw;
    F.tid = threadIdx.x; F.lane = F.tid & 63; F.wave = __builtin_amdgcn_readfirstlane(F.tid >> 6);
    F.G = gridDim.x; { const int bx = blockIdx.x; F.vcu = (F.G % 8 == 0) ? (bx % 8) * (F.G / 8) + bx / 8 : bx; }
    F.gw = blockIdx.x * NWAVES + F.wave; F.ngw = F.G * NWAVES;
    F.ws = args.ws; F.out = args.out;
    F.a = &args;
    volatile LAS unsigned* MISC = (volatile LAS unsigned*)(F.lds + MISC_OFF);
    for (int u = F.tid; u < (LDS_BYTES - RING_BYTES) / 4; u += NTHR) ((LAS unsigned*)(F.lds + RING_BYTES))[u] = 0u;
    __syncthreads();
    const int lo = args.ph_lo, hi = args.ph_hi;
    const bool multi = (hi - lo) > 1;
    XcdBarrier bar; bar.bar = (unsigned*)(F.ws + WS_CTL) + CW_BAR; bar.x = 0; bar.st = nullptr;
    if (multi) bar = xcd_barrier_post((unsigned*)(F.ws + WS_CTL) + CW_BAR, MISC + 8);
#define IN(k) (lo <= (k) && (k) < hi)
#define SEAM(k) do { if (IN(k) && IN((k) + 1)) xcd_barrier(bar); } while (0)
#ifndef DUP_MASK
#define DUP_MASK 0u

#endif
#define PHASE(k, ...) do { if (IN(k)) { __VA_ARGS__ if ((DUP_MASK >> (k)) & 1u) { xcd_barrier(bar); __VA_ARGS__ } } SEAM(k); } while (0)
    using namespace pg8;
    bf16_t* A1 = (bf16_t*)(F.ws + WS_A1); bf16_t* Zb = (bf16_t*)(F.ws + WS_Z); bf16_t* Y1 = (bf16_t*)(F.ws + WS_Y1);
    bf16_t* XS = (bf16_t*)(F.ws + WS_XS); unsigned char* HID = (unsigned char*)(F.ws + WS_HID); bf16_t* Ub = (bf16_t*)(F.ws + WS_U);
    bf16_t* ZG = (bf16_t*)(F.ws + WS_ZG); bf16_t* ZZ = (bf16_t*)(F.ws + WS_ZZ);
    float* MOD = (float*)(F.ws + WS_MOD);

    constexpr int PW_ATT = 16 * 64 + 8 * 32, PW_ALL = PW_ATT + 3 * 16 * 32;
    const bool split0 = (F.G == 256);
    PHASE(0, { if (split0) { p0_mod(F, 0, 1, 0, 96); p0_tables(F, 96, 16); p0_poolfold(F, 1024, 1024); p0_weights(F, 0, PW_ATT, 96 * 8, 160 * 8); }
               else { p0_mod(F, 0, 2, 0, F.G); p0_tables(F, 0, F.G); p0_poolfold(F, 0, F.ngw); p0_weights(F, 0, PW_ALL, 0, F.ngw); } });
    PHASE(1, { phase_norm1_l0(F); p1_ktab(F); });
    PHASE(2, { Gemm g{A1, (const bf16_t*)(F.ws + WS_WIN), 1024, 1024, 1024, 0, 0}; OrdDense S; S.init(NTOK / 256, 8, F.G, (int)blockIdx.x);
        EpiInProj E{Zb, (const float*)(F.ws + WS_ROPE), (const float*)(F.ws + WS_ROPE) + 128 * 16};
        gemm_phase<EpiInProj, OrdDense>(F.lds, g, S, E); p2_operators(F); });
    PHASE(3, { phase_attn(F); });
    PHASE(4, { Gemm g{Y1, (const bf16_t*)(F.ws + WS_WOUT), 1024, 1024, 1024, 0, 0}; OrdDense S; S.init(NTOK / 256, 4, F.G, (int)blockIdx.x);
        EpiResid E{F.a->in[0], F.a->in[2], (bf16_t*)(F.ws + WS_HB), MOD, 1};
        gemm_phase<EpiResid, OrdDense>(F.lds, g, S, E);
        if (split0) { __syncthreads(); p0_mod(F, 1, 2, 160, 96); p0_weights(F, PW_ATT, PW_ALL, 16 * 8, 240 * 8); } });
    PHASE(5, { phase_norm2_router(F, 0, true); });
    PHASE(6, { phase_select(F, true); });
    PHASE(8, { Gemm g{A1, (const bf16_t*)(F.ws + WS_GU), 1024, 1024, 1024, 0, (size_t)4096 * 1024}; OrdGrouped S; S.init(16, 16, 16, 1, F.G, F.vcu);
        EpiGateUp E{HID, 1.0f}; gemm_phase_f8<EpiGateUp, OrdGrouped, true>(F.lds, g, S, E, (const int*)(F.ws + WS_TOK), XROWS, NTOK); });
    PHASE(9, { Gemm g{(const bf16_t*)HID, (const bf16_t*)(F.ws + WS_DN), 2048, 2048, 2048, (size_t)XROWS * 2048, (size_t)1024 * 2048}; OrdGrouped S; S.init(16, 16, 4, 1, F.G, F.vcu);
        EpiF8Out E{(unsigned char*)XS, 1024, (size_t)XROWS * 1024}; gemm_phase_f8<EpiF8Out, OrdGrouped>(F.lds, g, S, E); });
#ifdef PROBE_P10
    if (IN(10)) { phase_combine(F, 0, true, 0, true); xcd_barrier(bar); }
#endif
    PHASE(10, { phase_combine(F, 0, true, 0); });
    PHASE(11, { Gemm g{A1, (const bf16_t*)(F.ws + WS_SWIN), 1024, 1024, 1024, 0, 0}; OrdDense S; S.init(NTOK / 256, 4, F.G, (int)blockIdx.x);
        EpiSsmIn E{Ub}; gemm_phase_f8<EpiSsmIn, OrdDense>(F.lds, g, S, E); });
    PHASE(12, { Gemm g{Ub, (const bf16_t*)(F.ws + WS_POP), UK, 512, 512, (size_t)UROWS * UK, (size_t)256 * 512}; OrdGrouped S; S.init(64, 5, 1, 0, F.G, F.vcu);
        EpiF32 E{(float*)(F.ws + WS_SLOC), 256, (size_t)UROWS * 256}; gemm_phase<EpiF32, OrdGrouped>(F.lds, g, S, E); });
    PHASE(13, { phase_scan(F); });
    PHASE(14, { Gemm g{Ub, (const bf16_t*)(F.ws + WS_TQ), UK, UK, UK, (size_t)UROWS * UK, (size_t)512 * UK}; OrdGrouped S; S.init(64, 4, 2, 0, F.G, F.vcu);
        EpiSsmY E{ZG}; gemm_phase<EpiSsmY, OrdGrouped>(F.lds, g, S, E); });
    PHASE(15, { Gemm g{ZG, (const bf16_t*)(F.ws + WS_SWGLU), 1024, 1024, 1024, 0, 0}; OrdDense S; S.init(NLAT / 256, 4, F.G, (int)blockIdx.x);
        EpiGlu E{ZG, ZZ}; gemm_phase<EpiGlu, OrdDense>(F.lds, g, S, E); });
    PHASE(16, { Gemm g{ZZ, (const bf16_t*)(F.ws + WS_SWOUT), 1024, 1024, 1024, 0, 0}; OrdDense S; S.init(NLAT / 256, 4, F.G, (int)blockIdx.x);
        EpiResid E{nullptr, nullptr, (bf16_t*)(F.ws + WS_HB), MOD + 5 * 6144, 0}; gemm_phase_f8<EpiResid, OrdDense>(F.lds, g, S, E); });
    PHASE(17, { phase_norm2_router(F, 1, false); });
    PHASE(18, { phase_select(F, false); });
    PHASE(20, { Gemm g{A1, (const bf16_t*)(F.ws + WS_GU + (size_t)16 * 4096 * 1024), 1024, 1024, 1024, 0, (size_t)4096 * 1024}; OrdGrouped S; S.init(16, 16, 16, 0, F.G, F.vcu);
        EpiGateUp E{HID, 1.0f}; gemm_phase_f8<EpiGateUp, OrdGrouped, true>(F.lds, g, S, E, (const int*)(F.ws + WS_TOK), XROWS, NTOK); });
    PHASE(21, { Gemm g{(const bf16_t*)HID, (const bf16_t*)(F.ws + WS_DN + (size_t)16 * 1024 * 2048), 2048, 2048, 2048, (size_t)XROWS * 2048, (size_t)1024 * 2048}; OrdGrouped S; S.init(16, 16, 4, 0, F.G, F.vcu);
        EpiF8Out E{(unsigned char*)XS, 1024, (size_t)XROWS * 1024}; gemm_phase_f8<EpiF8Out, OrdGrouped>(F.lds, g, S, E); });
#ifdef PROBE_P22
    if (IN(22)) { phase_combine(F, 1, false, 1, true); xcd_barrier(bar); }
#endif
    PHASE(22, { phase_combine(F, 1, false, 1); });
#undef IN
#undef SEAM
}

#ifndef MK_ONE_LAUNCH
#define MK_ONE_LAUNCH 1
#endif
extern "C" void kernel_launch(void* const* d_in, const int* in_sizes, int n_in, void* d_out, int out_size, void* d_ws, size_t ws_size, hipStream_t stream) {
    static int grid = 0;
    if (grid == 0) {
        if (n_in != 33 || out_size != NLAT * DM || ws_size < WS_END) { fprintf(stderr, "kernel_launch: unexpected shapes: n_in %d out %d ws %zu (need %zu)\n", n_in, out_size, ws_size, (size_t)WS_END); grid = -1; return; }
        int dev = 0, cus = 0;
        if (hipGetDevice(&dev) != hipSuccess || hipDeviceGetAttribute(&cus, hipDeviceAttributeMultiprocessorCount, dev) != hipSuccess) { grid = -1; return; }
        if (hipFuncSetAttribute((const void*)mega_fwd, hipFuncAttributeMaxDynamicSharedMemorySize, LDS_BYTES) != hipSuccess) { fprintf(stderr, "kernel_launch: hipFuncSetAttribute failed\n"); grid = -1; return; }
        int per_cu = 0; (void)hipOccupancyMaxActiveBlocksPerMultiprocessor(&per_cu, (const void*)mega_fwd, NTHR, LDS_BYTES); (void)hipGetLastError();
        if (per_cu < 1) fprintf(stderr, "kernel_launch: occupancy query reports %d blocks per CU\n", per_cu);
        grid = cus;
    }
    if (grid < 0) return;
    (void)hipMemsetAsync((char*)d_ws + WS_CTL, 0, CTL_ZERO_BYTES, stream);
    Args a{};
    for (int i = 0; i < 33; ++i) a.in[i] = (const float*)d_in[i];
    a.out = (float*)d_out; a.ws = (unsigned char*)d_ws;
#if MK_ONE_LAUNCH
    a.ph_lo = 0; a.ph_hi = N_PHASES;
    hipLaunchKernelGGL(mega_fwd, dim3(grid), dim3(NTHR), LDS_BYTES, stream, a);
#else
    for (int p = 0; p < N_PHASES; ++p) { a.ph_lo = p; a.ph_hi = p + 1; hipLaunchKernelGGL(mega_fwd, dim3(grid), dim3(NTHR), LDS_BYTES, stream, a); }
#endif
}
```
